# Optimizing an MI355X kernel written in HIP

```python
import math
import jax, jax.numpy as jnp
from jax import lax
import numpy as np

D_MODEL = 1024
BATCH = 2
SEQ = 8192
DEPTH = 2

DA_HEADS = 4
DA_QK = 64
DA_V = 2 * DA_QK
DA_WIDTH = DA_HEADS * DA_V
ROPE_DIM = DA_QK // 4
ROPE_THETA = 500000.0
Q_BLOCK = 128
SC_WIDTH = 256
SC_CONV = 3
S5_WIDTH = 256
S5_GROUP = 16
S5_GROUPS = S5_WIDTH // S5_GROUP
S5_STATE = 64
M2_HEADS = 4
M2_HEAD_DIM = 64
M2_WIDTH = M2_HEADS * M2_HEAD_DIM
M2_GROUPS = 2
M2_STATE = 128
M2_CONV = 4
M2_CHUNK = 128
M2_XBC = M2_WIDTH + 2 * M2_GROUPS * M2_STATE
D_MIX = DA_WIDTH + SC_WIDTH + S5_WIDTH + M2_WIDTH
OFF_Q = 0
OFF_K = OFF_Q + DA_WIDTH
OFF_V = OFF_K + DA_WIDTH
OFF_SC = OFF_V + DA_WIDTH
OFF_S5 = OFF_SC + 3 * SC_WIDTH
OFF_M2Z = OFF_S5 + S5_WIDTH
OFF_M2XBC = OFF_M2Z + M2_WIDTH
OFF_M2DT = OFF_M2XBC + M2_XBC
D_PROJ = OFF_M2DT + M2_HEADS
D_FF = 2816
FFN_CONV = 3
EPS = 1e-6

kernel_name = "hybrid_parallel_heads_diffattn_shortconv_s5_ssd"


def rmsnorm(x, g):
    xf = x.astype(jnp.float32)
    y = xf * lax.rsqrt(jnp.mean(xf * xf, axis=-1, keepdims=True) + EPS)
    return (y * g.astype(jnp.float32)).astype(x.dtype)


def causal_dwconv(x, w):
    k_w, ch = w.shape
    return lax.conv_general_dilated(
        x, w[:, None, :].astype(x.dtype), window_strides=(1,), padding=[(k_w - 1, 0)],
        dimension_numbers=('NWC', 'WIO', 'NWC'), feature_group_count=ch)


def rope_tables(seq):
    inv = 1.0 / (ROPE_THETA ** (jnp.arange(0, ROPE_DIM, 2, dtype=jnp.float32) / ROPE_DIM))
    ang = jnp.arange(seq, dtype=jnp.float32)[:, None] * inv[None, :]
    return jnp.cos(ang), jnp.sin(ang)


def partial_rope(x, cos, sin):
    xr = x[..., :ROPE_DIM].astype(jnp.float32)
    half = ROPE_DIM // 2
    x1, x2 = xr[..., :half], xr[..., half:]
    c = cos[:, None, None, :]
    s = sin[:, None, None, :]
    rot = jnp.concatenate([x1 * c - x2 * s, x1 * s + x2 * c], axis=-1).astype(x.dtype)
    return jnp.concatenate([rot, x[..., ROPE_DIM:]], axis=-1)


def diff_attention(q, k, v, lam, lambda_init, sub_g):
    bsz, seq, nh, _, d = q.shape
    nb = seq // Q_BLOCK
    scale = d ** -0.5
    qb = q.reshape(bsz, nb, Q_BLOCK, nh, 2, d).transpose(1, 0, 2, 3, 4, 5)
    kpos = jnp.arange(seq)

    def block(args):
        qi, i = args
        s = jnp.einsum('bqhcd,bkhcd->bhcqk', qi, k).astype(jnp.float32) * scale
        qpos = i * Q_BLOCK + jnp.arange(Q_BLOCK)
        s = jnp.where(kpos[None, :] <= qpos[:, None], s, -jnp.inf)
        p = jax.nn.softmax(s, axis=-1)
        a = p[:, :, 0] - lam * p[:, :, 1]
        return jnp.einsum('bhqk,bkhe->bqhe', a.astype(v.dtype), v)

    o = lax.map(block, (qb, jnp.arange(nb)))
    o = o.transpose(1, 0, 2, 3, 4).reshape(bsz, seq, nh, 2 * d)
    o = rmsnorm(o, sub_g) * (1.0 - lambda_init)
    return o.reshape(bsz, seq, nh * 2 * d)


def s5_mixer(u, lam_re, lam_im, log_dt, b_re, b_im, c_re, c_im, d_skip, w_glu, b_glu):
    bsz, seq, _ = u.shape
    f32 = jnp.float32
    uf = u.astype(f32).reshape(bsz, seq, S5_GROUPS, S5_GROUP)
    lam = lax.complex(lam_re.astype(f32), lam_im.astype(f32))
    dt = jnp.exp(log_dt.astype(f32))[:, None]
    lam_bar = jnp.exp(lam * dt)
    b = lax.complex(b_re.astype(f32), b_im.astype(f32))
    b_bar = ((lam_bar - 1.0) / lam)[..., None] * b
    bu = jnp.einsum('bsgh,gph->bsgp', uf.astype(jnp.complex64), b_bar)
    a = jnp.broadcast_to(lam_bar, bu.shape)

    def comb(e1, e2):
        a1, x1 = e1
        a2, x2 = e2
        return a2 * a1, a2 * x1 + x2

    _, xs = lax.associative_scan(comb, (a, bu), axis=1)
    c = lax.complex(c_re.astype(f32), c_im.astype(f32))
    y = jnp.einsum('bsgp,ghp->bsgh', xs, c).real \
        + d_skip.astype(f32).reshape(S5_GROUPS, S5_GROUP) * uf
    y = y.reshape(bsz, seq, S5_WIDTH)
    g = jax.nn.gelu(y)
    out = g * jax.nn.sigmoid(g @ w_glu.astype(f32) + b_glu.astype(f32))
    return out.astype(u.dtype)


def segsum(a):
    cs = jnp.cumsum(a, axis=-1)
    seg = cs[..., :, None] - cs[..., None, :]
    n = a.shape[-1]
    return jnp.where(jnp.tril(jnp.ones((n, n), dtype=bool)), seg, -jnp.inf)


def ssd_chunked(x, a, b, c):
    bsz, seq, nh, hp = x.shape
    ns = b.shape[-1]
    nc = seq // M2_CHUNK
    x = x.reshape(bsz, nc, M2_CHUNK, nh, hp)
    b = b.reshape(bsz, nc, M2_CHUNK, nh, ns)
    c = c.reshape(bsz, nc, M2_CHUNK, nh, ns)
    a = a.reshape(bsz, nc, M2_CHUNK, nh).transpose(0, 3, 1, 2)
    a_cs = jnp.cumsum(a, axis=-1)
    decay = jnp.exp(segsum(a))
    scores = jnp.einsum('bclhn,bcshn->bhcls', c, b) * decay
    y_diag = jnp.einsum('bhcls,bcshp->bclhp', scores, x)
    decay_states = jnp.exp(a_cs[..., -1:] - a_cs)
    states = jnp.einsum('bclhn,bhcl,bclhp->bchpn', b, decay_states, x)
    chunk_decay = jnp.exp(a_cs[..., -1])

    def step(h, inp):
        st, dec = inp
        return dec[..., None, None] * h + st, h

    h0 = jnp.zeros((bsz, nh, hp, ns), jnp.float32)
    _, h_in = lax.scan(step, h0, (states.transpose(1, 0, 2, 3, 4), chunk_decay.transpose(2, 0, 1)))
    h_in = h_in.transpose(1, 0, 2, 3, 4)
    y_off = jnp.einsum('bclhn,bchpn,bhcl->bclhp', c, h_in, jnp.exp(a_cs))
    return (y_diag + y_off).reshape(bsz, seq, nh, hp)


def mamba2_mixer(z, xbc, dt_raw, conv_w, conv_b, dt_bias, a_log, d_skip, norm_g):
    bsz, seq, _ = z.shape
    f32 = jnp.float32
    xbc = jax.nn.silu((causal_dwconv(xbc, conv_w) + conv_b.astype(xbc.dtype)).astype(f32))
    xs = xbc[..., :M2_WIDTH].reshape(bsz, seq, M2_HEADS, M2_HEAD_DIM)
    bm = xbc[..., M2_WIDTH:M2_WIDTH + M2_GROUPS * M2_STATE].reshape(bsz, seq, M2_GROUPS, M2_STATE)
    cm = xbc[..., M2_WIDTH + M2_GROUPS * M2_STATE:].reshape(bsz, seq, M2_GROUPS, M2_STATE)
    rep = M2_HEADS // M2_GROUPS
    bm = jnp.repeat(bm, rep, axis=2)
    cm = jnp.repeat(cm, rep, axis=2)
    dt = jax.nn.softplus(dt_raw.astype(f32) + dt_bias.astype(f32))
    a = -jnp.exp(a_log.astype(f32))
    y = ssd_chunked(xs * dt[..., None], a * dt, bm, cm)
    y = y + d_skip.astype(f32)[:, None] * xs
    y = y.reshape(bsz, seq, M2_WIDTH)
    y = rmsnorm(y * jax.nn.silu(z.astype(f32)), norm_g)
    return y.astype(z.dtype)


def setup_inputs(seed: int = 0) -> dict:
    key = jax.random.key(seed)
    ks = iter(jax.random.split(key, 48))
    f32 = jnp.float32

    def nrm(shape, scale):
        return jax.random.normal(next(ks), shape, f32) * scale

    L = DEPTH
    n = jnp.arange(S5_STATE, dtype=f32)
    m2_dt = jnp.exp(jax.random.uniform(next(ks), (L, M2_HEADS), f32, math.log(1e-3), math.log(1e-1)))
    return {
        "x": nrm((BATCH, SEQ, D_MODEL), 1.0),
        "ln1_g": 1.0 + nrm((L, D_MODEL), 0.02),
        "w_in": nrm((L, D_MODEL, D_PROJ), D_MODEL ** -0.5),
        "qk_norm_g": 1.0 + nrm((L, 2, DA_QK), 0.02),
        "da_lambda": nrm((L, 4, DA_QK), 0.1),
        "subln_g": 1.0 + nrm((L, DA_V), 0.02),
        "sc_conv_w": nrm((L, SC_CONV, SC_WIDTH), SC_CONV ** -0.5),
        "s5_lam_re": -0.5 + nrm((L, S5_GROUPS, S5_STATE), 0.01),
        "s5_lam_im": math.pi * n + nrm((L, S5_GROUPS, S5_STATE), 0.01),
        "s5_log_dt": jax.random.uniform(next(ks), (L, S5_GROUPS), f32, math.log(1e-3), math.log(1e-1)),
        "s5_b_re": nrm((L, S5_GROUPS, S5_STATE, S5_GROUP), (2 * S5_GROUP) ** -0.5),
        "s5_b_im": nrm((L, S5_GROUPS, S5_STATE, S5_GROUP), (2 * S5_GROUP) ** -0.5),
        "s5_c_re": nrm((L, S5_GROUPS, S5_GROUP, S5_STATE), (2 * S5_STATE) ** -0.5),
        "s5_c_im": nrm((L, S5_GROUPS, S5_GROUP, S5_STATE), (2 * S5_STATE) ** -0.5),
        "s5_d": nrm((L, S5_WIDTH), 1.0),
        "s5_w_glu": nrm((L, S5_WIDTH, S5_WIDTH), S5_WIDTH ** -0.5),
        "s5_b_glu": nrm((L, S5_WIDTH), 0.01),
        "m2_conv_w": nrm((L, M2_CONV, M2_XBC), M2_CONV ** -0.5),
        "m2_conv_b": nrm((L, M2_XBC), 0.01),
        "m2_dt_bias": m2_dt + jnp.log(-jnp.expm1(-m2_dt)),
        "m2_a_log": jnp.log(jax.random.uniform(next(ks), (L, M2_HEADS), f32, 1.0, 16.0)),
        "m2_d": 1.0 + nrm((L, M2_HEADS), 0.1),
        "m2_norm_g": 1.0 + nrm((L, M2_WIDTH), 0.02),
        "w_out": nrm((L, D_MIX, D_MODEL), D_MIX ** -0.5),
        "ln2_g": 1.0 + nrm((L, D_MODEL), 0.02),
        "ffn_w_gate": nrm((L, D_MODEL, D_FF), D_MODEL ** -0.5),
        "ffn_w_up": nrm((L, D_MODEL, D_FF), D_MODEL ** -0.5),
        "ffn_conv_w": nrm((L, FFN_CONV, D_FF), FFN_CONV ** -0.5),
        "ffn_w_down": nrm((L, D_FF, D_MODEL), D_FF ** -0.5),
    }


def reference(x, ln1_g, w_in, qk_norm_g, da_lambda, subln_g, sc_conv_w,
              s5_lam_re, s5_lam_im, s5_log_dt, s5_b_re, s5_b_im, s5_c_re, s5_c_im,
              s5_d, s5_w_glu, s5_b_glu, m2_conv_w, m2_conv_b, m2_dt_bias, m2_a_log,
              m2_d, m2_norm_g, w_out, ln2_g, ffn_w_gate, ffn_w_up, ffn_conv_w, ffn_w_down):
    bsz, seq, _ = x.shape
    cos, sin = rope_tables(seq)
    for l in range(DEPTH):
        h = rmsnorm(x, ln1_g[l])
        proj = h @ w_in[l]

        q = proj[..., OFF_Q:OFF_K].reshape(bsz, seq, DA_HEADS, 2, DA_QK)
        k = proj[..., OFF_K:OFF_V].reshape(bsz, seq, DA_HEADS, 2, DA_QK)
        v = proj[..., OFF_V:OFF_SC].reshape(bsz, seq, DA_HEADS, DA_V)
        q = partial_rope(rmsnorm(q, qk_norm_g[l, 0]), cos, sin)
        k = partial_rope(rmsnorm(k, qk_norm_g[l, 1]), cos, sin)
        lam_p = da_lambda[l].astype(jnp.float32)
        lambda_init = 0.8 - 0.6 * math.exp(-0.3 * l)
        lam = jnp.exp(jnp.sum(lam_p[0] * lam_p[1])) - jnp.exp(jnp.sum(lam_p[2] * lam_p[3])) + lambda_init
        o_a = diff_attention(q, k, v, lam, lambda_init, subln_g[l])

        sc_b = proj[..., OFF_SC:OFF_SC + SC_WIDTH]
        sc_c = proj[..., OFF_SC + SC_WIDTH:OFF_SC + 2 * SC_WIDTH]
        sc_h = proj[..., OFF_SC + 2 * SC_WIDTH:OFF_S5]
        o_b = sc_b * causal_dwconv(sc_c * sc_h, sc_conv_w[l])

        o_c = s5_mixer(proj[..., OFF_S5:OFF_M2Z], s5_lam_re[l], s5_lam_im[l], s5_log_dt[l],
                       s5_b_re[l], s5_b_im[l], s5_c_re[l], s5_c_im[l], s5_d[l],
                       s5_w_glu[l], s5_b_glu[l])

        o_d = mamba2_mixer(proj[..., OFF_M2Z:OFF_M2XBC], proj[..., OFF_M2XBC:OFF_M2DT],
                           proj[..., OFF_M2DT:D_PROJ], m2_conv_w[l], m2_conv_b[l],
                           m2_dt_bias[l], m2_a_log[l], m2_d[l], m2_norm_g[l])

        mixed = jnp.concatenate([o_a.astype(x.dtype), o_b.astype(x.dtype),
                                 o_c.astype(x.dtype), o_d.astype(x.dtype)], axis=-1)
        x = x + mixed @ w_out[l]

        h2 = rmsnorm(x, ln2_g[l])
        g = causal_dwconv(h2 @ ffn_w_gate[l], ffn_conv_w[l])
        x = x + (jax.nn.silu(g) * (h2 @ ffn_w_up[l])) @ ffn_w_down[l]
    return x
```

```cpp
#include <hip/hip_runtime.h>
#include <hip/hip_cooperative_groups.h>
#include <cstdio>
#include <cstdint>
namespace cg = cooperative_groups;
namespace pg8 {
#define PG8_LAS __attribute__((address_space(3)))
typedef unsigned short bf16_t;
typedef short bf16x8 __attribute__((ext_vector_type(8)));
typedef float f32x4 __attribute__((ext_vector_type(4)));
typedef unsigned u32x4 __attribute__((ext_vector_type(4)));
constexpr int BM = 256, BK = 64, HALF = 128, HTB = HALF * BK * 2  , STAGE_BYTES = 8 * HTB, NXCD = 8, WGM = 8;

__host__ __device__ __forceinline__ int lds_byte(int r, int c) { const int st = (r >> 4) * 2 + (c >> 5), rr = r & 15, cc = c & 31, ob = rr * 64 + cc * 2; return st * 1024 + (ob ^ (((ob >> 9) & 1) << 5)); }
__host__ __device__ __forceinline__ void stage_rc(int b, int& R, int& C) { const int st = b / 1024, sb = b % 1024, swz = sb ^ (((sb >> 9) & 1) << 5); R = (st >> 1) * 16 + swz / 64; C = (st & 1) * 32 + (swz % 64) / 2; }
__host__ __device__ __forceinline__ int perm32(int rho) { const int n = rho >> 4, i = rho & 15; return 8 * (i >> 2) + 4 * n + (i & 3); }

struct Unit { int pm, pn; };
struct Gemm { const bf16_t* A; const bf16_t* Bt; int M, N, K, lda; };

struct StaticOrder {
    int nM, nN, nwg, G, c;
    __host__ __device__ void init(int M, int N, int G_, int c_) { nM = M / BM; nN = N / BM; nwg = nM * nN; G = G_; c = c_; }
    __host__ __device__ bool next(int i, Unit& u) const {
        const long L = (long)i * G + c; if (L >= nwg) return false;
        int wgid = (int)L; { const int q = nwg / NXCD, r = nwg % NXCD, xcd = wgid % NXCD, off = wgid / NXCD; wgid = (xcd < r ? xcd * (q + 1) : r * (q + 1) + (xcd - r) * q) + off; }
        const int nig = WGM * nN, gid = wgid / nig, fm = gid * WGM, gsz = (nM - fm) < WGM ? (nM - fm) : WGM;
        u.pm = fm + ((wgid % nig) % gsz); u.pn = (wgid % nig) / gsz; return true;
    }
    __device__ __forceinline__ void a_ready(const Unit&) const {}
    __device__ __forceinline__ void done(const Unit&) const {}
};

__device__ __forceinline__ unsigned cvt_pk_bf16(float lo, float hi) { unsigned r; asm volatile("v_cvt_pk_bf16_f32 %0, %1, %2" : "=v"(r) : "v"(lo), "v"(hi)); return r; }
template <class Epi, class Sched, bool ALIGN_EPI = false, bool SP2 = false>
__device__ __forceinline__ void gemm_phase(PG8_LAS unsigned char* lds, const Gemm g, const Sched& S, const Epi& E) {
    int tid_ = threadIdx.x; asm volatile("" : "+v"(tid_)); const int tid = tid_, wid = __builtin_amdgcn_readfirstlane(tid >> 6), lane = tid & 63, wr = wid >> 2, wc = wid & 3, fr = lane & 15, fq = lane >> 4;
    const int K = g.K, nt = K / BK;
    unsigned voffA[2], voffB[2];
#pragma unroll
    for (int i = 0; i < 2; ++i) { int R, C; stage_rc(tid * 16 + i * 8192, R, C); const int Rb = Epi::PERM ? ((R & ~31) + perm32(R & 31)) : R;
        const int Ra = Epi::OVL ? (R - 2 * (R >> 6)) : R; voffA[i] = (unsigned)(Ra * g.lda + C) * 2u; voffB[i] = (unsigned)(Rb * K + C) * 2u; }
    const size_t kstep = (size_t)(BK * 2);
    const size_t hstepB = (size_t)HALF * K * 2, tstepB = 2 * hstepB;
    const size_t hstepA = (size_t)(Epi::OVL ? 124 : HALF) * g.lda * 2, tstepA = 2 * hstepA;
    const unsigned ldsw = (unsigned)wid * 1024u;
    const int aoff = lds_byte(wr * 64 + fr, fq * 8), boff = lds_byte(wc * 32 + fr, fq * 8);
#define PG8_SA(b, h) (((b) * 2 + (h)) * HTB)
#define PG8_SB(b, h) ((4 + (b) * 2 + (h)) * HTB)
#define PG8_STAGE(bufoff, gbase, voff) do { _Pragma("unroll") for (int _i = 0; _i < 2; ++_i) \
        __builtin_amdgcn_global_load_lds((const unsigned*)((const char*)(gbase) + (voff)[_i]), (PG8_LAS unsigned*)(lds + (bufoff) + ldsw + _i * 8192), 16, 0, 0); } while (0)
#define PG8_LDA(dst, b, h) do { _Pragma("unroll") for (int m = 0; m < 4; ++m) _Pragma("unroll") for (int k = 0; k < 2; ++k) dst[m][k] = *(const PG8_LAS bf16x8*)(lds + PG8_SA(b, h) + aoff + m * 2048 + k * 1024); } while (0)
#define PG8_LDB(dst, b, h) do { _Pragma("unroll") for (int n = 0; n < 2; ++n) _Pragma("unroll") for (int k = 0; k < 2; ++k) dst[n][k] = *(const PG8_LAS bf16x8*)(lds + PG8_SB(b, h) + boff + n * 2048 + k * 1024); } while (0)
#define PG8_MMA(ai, bj, At, Bt) do { __builtin_amdgcn_s_setprio(1); _Pragma("unroll") for (int m = 0; m < 4; ++m) _Pragma("unroll") for (int n = 0; n < 2; ++n) _Pragma("unroll") for (int k = 0; k < 2; ++k) \
        acc[ai][bj][m][n] = __builtin_amdgcn_mfma_f32_16x16x32_bf16(Bt[n][k], At[m][k], acc[ai][bj][m][n], 0, 0, 0); __builtin_amdgcn_s_setprio(0); } while (0)
#define PG8_WAIT_V(n) asm volatile("s_waitcnt vmcnt(" #n ")" ::: "memory")
#define PG8_WAIT_L(n) asm volatile("s_waitcnt lgkmcnt(" #n ")" ::: "memory")
#define PG8_BAR __builtin_amdgcn_s_barrier()
#define PG8_SCHED __builtin_amdgcn_sched_barrier(0)
    Unit cur, nxt; int ui = 0;
    if (!S.next(0, cur)) return;
    f32x4 acc[2][2][4][2];
#pragma unroll
    for (int a = 0; a < 2; ++a)
#pragma unroll
        for (int b = 0; b < 2; ++b)
#pragma unroll
            for (int m = 0; m < 4; ++m)
#pragma unroll
                for (int n = 0; n < 2; ++n) acc[a][b][m][n] = (f32x4){0.f, 0.f, 0.f, 0.f};
    bf16x8 At[4][2], B0[2][2], B1[2][2];
    const char* cA = (const char*)g.A + (size_t)cur.pm * tstepA; const char* cB = (const char*)g.Bt + (size_t)cur.pn * tstepB;
    S.a_ready(cur);
    if constexpr (SP2) {
        PG8_STAGE(PG8_SB(0, 0), cB, voffB); PG8_STAGE(PG8_SB(0, 1), cB + hstepB, voffB); PG8_STAGE(PG8_SA(0, 0), cA, voffA); PG8_STAGE(PG8_SA(0, 1), cA + hstepA, voffA);
        if (wr == 1) PG8_BAR;
        PG8_WAIT_V(2); PG8_BAR;
        PG8_STAGE(PG8_SB(1, 0), cB + kstep, voffB); PG8_STAGE(PG8_SA(1, 0), cA + kstep, voffA); PG8_STAGE(PG8_SB(1, 1), cB + hstepB + kstep, voffB);
        PG8_WAIT_V(6); PG8_BAR;
    } else {
        PG8_STAGE(PG8_SB(0, 0), cB, voffB); PG8_STAGE(PG8_SA(0, 0), cA, voffA); PG8_STAGE(PG8_SB(0, 1), cB + hstepB, voffB); PG8_STAGE(PG8_SA(0, 1), cA + hstepA, voffA);
        if (wr == 1) PG8_BAR;
        PG8_WAIT_V(4); PG8_BAR;
        PG8_STAGE(PG8_SB(1, 0), cB + kstep, voffB); PG8_STAGE(PG8_SA(1, 0), cA + kstep, voffA); PG8_STAGE(PG8_SB(1, 1), cB + hstepB + kstep, voffB);
        PG8_WAIT_V(6); PG8_BAR;
    }
    for (;;) {
        const bool has_next = S.next(ui + 1, nxt);
        const char* nA = has_next ? (const char*)g.A + (size_t)nxt.pm * tstepA : cA; const char* nB = has_next ? (const char*)g.Bt + (size_t)nxt.pn * tstepB : cB;
        for (int t = 0; t < nt; t += 2) {
            const bool last = (t == nt - 2);
            const char* a1 = cA + (size_t)(t + 1) * kstep;
            const char* a2 = last ? nA : cA + (size_t)(t + 2) * kstep; const char* b2 = last ? nB : cB + (size_t)(t + 2) * kstep;
            const char* a3 = a2 + kstep; const char* b3 = b2 + kstep;
            if (last && has_next) S.a_ready(nxt);
            if constexpr (SP2) {
            PG8_LDB(B0, 0, 0); PG8_LDB(B1, 0, 1); PG8_SCHED; PG8_LDA(At, 0, 0); PG8_STAGE(PG8_SA(1, 1), a1 + hstepA, voffA);
            PG8_WAIT_V(8); PG8_WAIT_L(0); PG8_BAR; PG8_MMA(0, 0, At, B0); PG8_MMA(0, 1, At, B1); PG8_BAR; PG8_SCHED;
            PG8_LDA(At, 0, 1); PG8_STAGE(PG8_SB(0, 0), b2, voffB); PG8_STAGE(PG8_SB(0, 1), b2 + hstepB, voffB); PG8_STAGE(PG8_SA(0, 0), a2, voffA);
            PG8_WAIT_V(8); PG8_WAIT_L(0); PG8_BAR; PG8_MMA(1, 0, At, B0); PG8_MMA(1, 1, At, B1); PG8_BAR; PG8_SCHED;
            PG8_LDB(B0, 1, 0); PG8_LDB(B1, 1, 1); PG8_SCHED; PG8_LDA(At, 1, 0); PG8_STAGE(PG8_SA(0, 1), a2 + hstepA, voffA);
            PG8_WAIT_V(8); PG8_WAIT_L(0); PG8_BAR; PG8_MMA(0, 0, At, B0); PG8_MMA(0, 1, At, B1); PG8_BAR; PG8_SCHED;
            PG8_LDA(At, 1, 1); PG8_STAGE(PG8_SB(1, 0), b3, voffB); PG8_STAGE(PG8_SB(1, 1), b3 + hstepB, voffB); PG8_STAGE(PG8_SA(1, 0), a3, voffA);
            PG8_WAIT_V(8); PG8_WAIT_L(0); PG8_BAR; PG8_MMA(1, 0, At, B0); PG8_MMA(1, 1, At, B1); PG8_BAR; PG8_SCHED;
            } else {
            PG8_LDB(B0, 0, 0); PG8_SCHED; PG8_LDA(At, 0, 0); PG8_STAGE(PG8_SA(1, 1), a1 + hstepA, voffA);
            PG8_WAIT_L(8); PG8_BAR; PG8_WAIT_L(0); PG8_MMA(0, 0, At, B0); PG8_BAR; PG8_SCHED;
            PG8_LDB(B1, 0, 1); PG8_STAGE(PG8_SB(0, 0), b2, voffB);
            PG8_BAR; PG8_WAIT_L(0); PG8_MMA(0, 1, At, B1); PG8_BAR;
            PG8_LDA(At, 0, 1); PG8_STAGE(PG8_SA(0, 0), a2, voffA);
            PG8_BAR; PG8_WAIT_L(0); PG8_MMA(1, 0, At, B0); PG8_BAR; PG8_SCHED;
            PG8_STAGE(PG8_SB(0, 1), b2 + hstepB, voffB);
            PG8_WAIT_V(6); PG8_BAR; PG8_MMA(1, 1, At, B1); PG8_BAR;
            PG8_LDB(B0, 1, 0); PG8_SCHED; PG8_LDA(At, 1, 0); PG8_STAGE(PG8_SA(0, 1), a2 + hstepA, voffA);
            PG8_WAIT_L(8); PG8_BAR; PG8_WAIT_L(0); PG8_MMA(0, 0, At, B0); PG8_BAR; PG8_SCHED;
            PG8_LDB(B1, 1, 1); PG8_STAGE(PG8_SB(1, 0), b3, voffB);
            PG8_BAR; PG8_WAIT_L(0); PG8_MMA(0, 1, At, B1); PG8_BAR;
            PG8_LDA(At, 1, 1); PG8_STAGE(PG8_SA(1, 0), a3, voffA);
            PG8_BAR; PG8_WAIT_L(0); PG8_MMA(1, 0, At, B0); PG8_BAR; PG8_SCHED;
            PG8_STAGE(PG8_SB(1, 1), b3 + hstepB, voffB);
            PG8_WAIT_V(6); PG8_BAR; PG8_MMA(1, 1, At, B1); PG8_BAR;
            }
        }
        if constexpr (ALIGN_EPI) { if (wr == 0) PG8_BAR; }
        if constexpr (!Epi::AFTER_DRAIN) { E(acc, cur, wr, wc, fr, fq); S.done(cur); }
        if (!has_next) break;
#pragma unroll
        for (int a = 0; a < 2; ++a)
#pragma unroll
            for (int b = 0; b < 2; ++b)
#pragma unroll
                for (int m = 0; m < 4; ++m)
#pragma unroll
                    for (int n = 0; n < 2; ++n) acc[a][b][m][n] = (f32x4){0.f, 0.f, 0.f, 0.f};
        cur = nxt; cA = nA; cB = nB; ++ui;
        if constexpr (ALIGN_EPI) { if (wr == 1) PG8_BAR; }
    }
    PG8_WAIT_V(0);
    if constexpr (!ALIGN_EPI) { if (wr == 0) PG8_BAR; }
    PG8_BAR;
    if constexpr (Epi::AFTER_DRAIN) { E.fused(acc, cur, wr, wc, fr, fq, lds, wid, lane); S.done(cur); }
#undef PG8_SA
#undef PG8_SB
#undef PG8_STAGE
#undef PG8_LDA
#undef PG8_LDB
#undef PG8_MMA
#undef PG8_WAIT_V
#undef PG8_WAIT_L
#undef PG8_BAR
#undef PG8_SCHED
}
}
#include <hip/hip_bf16.h>
#include <cmath>
namespace attn_body {
using bf16=__hip_bfloat16;
using bf16x8=__attribute__((ext_vector_type(8)))short;
using s16x4=__attribute__((ext_vector_type(4)))short;
using f32x16=__attribute__((ext_vector_type(16)))float;
using u32x4=__attribute__((ext_vector_type(4)))unsigned;
constexpr int BATCH=2,NHEAD=16,SEQ=8192,D=64,PQ=1024,PV=512,PO=1024;
constexpr int NW=8,QBLK=32,QB=QBLK*NW,KVBLK=64,NQB=SEQ/QB;
constexpr int ATTN_UNIT_ROWS=QB;
__device__ __forceinline__ int crow(int r,int hi){return (r&3)+8*(r>>2)+4*hi;}
#define SBAR() __builtin_amdgcn_sched_barrier(0)
__device__ __forceinline__ void cmask(f32x16&p0,f32x16&p1,int jb,int qrel,int hi){
  const float NEG=-INFINITY; int kb=64*jb+4*hi;
  #pragma unroll
  for(int r=0;r<16;++r){int kv=kb+(r&3)+8*(r>>2); if(kv>qrel)p0[r]=NEG; if(kv+32>qrel)p1[r]=NEG;}
}

constexpr int NSLOT=3, SLOTB=8192;
constexpr int LDS_K=0, LDS_V=NSLOT*SLOTB, LDS_WS=3*NSLOT*SLOTB, LDS_OST=LDS_WS+NW*64*4, LDS_BYTES=LDS_OST+NW*4096;
constexpr float C2=0.125f*1.4426950408889634f;
__device__ __forceinline__ void glds16(const void*gsrc,unsigned lds_dst){unsigned keep;
  asm volatile("s_mov_b32 %0, m0\n\ts_mov_b32 m0, %2\n\ts_nop 0\n\tglobal_load_lds_dwordx4 %1, off\n\ts_mov_b32 m0, %0":"=&s"(keep):"v"(gsrc),"s"(lds_dst):"memory");}
__device__ __forceinline__ float max3f(float a,float b,float c){float r;asm("v_max3_f32 %0, %1, %2, %3":"=v"(r):"v"(a),"v"(b),"v"(c));return r;}
__device__ __forceinline__ float max2f(float a,float b){float r;asm("v_max_f32_e32 %0, %1, %2":"=v"(r):"v"(a),"v"(b));return r;}
__device__ __forceinline__ float fadd_s(float a,float b){float r;asm("v_add_f32_e32 %0, %1, %2":"=v"(r):"v"(a),"v"(b));return r;}
__device__ __forceinline__ float fsub_s(float a,float b){float r;asm("v_sub_f32_e32 %0, %1, %2":"=v"(r):"v"(a),"v"(b));return r;}
typedef float f32x2_t __attribute__((ext_vector_type(2))); typedef __bf16 bf16x2_t __attribute__((ext_vector_type(2)));
__device__ __forceinline__ unsigned cvtpk_s(float lo,float hi){f32x2_t v={lo,hi};bf16x2_t b=__builtin_convertvector(v,bf16x2_t);return __builtin_bit_cast(unsigned,b);}
#define WAIT_BAR(N) asm volatile("s_waitcnt vmcnt(" #N ") lgkmcnt(0)\n\ts_barrier":::"memory")

__device__ __forceinline__ void qkt(f32x16&p0,f32x16&p1,const char*Kslot,const bf16x8*qr,const f32x16&negm,int r32,int hi){
  const char*kb=Kslot+hi*1024+r32*16;
  #pragma unroll
  for(int d0=0;d0<4;++d0){
    const bf16x8 b0=*reinterpret_cast<const bf16x8*>(kb+d0*2048);
    const bf16x8 b1=*reinterpret_cast<const bf16x8*>(kb+d0*2048+512);
    if(d0==0){p0=__builtin_amdgcn_mfma_f32_32x32x16_bf16(b0,qr[0],negm,0,0,0);p1=__builtin_amdgcn_mfma_f32_32x32x16_bf16(b1,qr[0],negm,0,0,0);}
    else{p0=__builtin_amdgcn_mfma_f32_32x32x16_bf16(b0,qr[d0],p0,0,0,0);p1=__builtin_amdgcn_mfma_f32_32x32x16_bf16(b1,qr[d0],p1,0,0,0);}}
}
typedef __attribute__((address_space(3))) const char* lds_cptr;
typedef short v4i16_t __attribute__((ext_vector_type(4)));
__device__ __forceinline__ void kload8(bf16x8*kf,lds_cptr kp){
  kf[0]=*(const __attribute__((address_space(3))) bf16x8*)(kp);      kf[1]=*(const __attribute__((address_space(3))) bf16x8*)(kp+512);
  kf[2]=*(const __attribute__((address_space(3))) bf16x8*)(kp+2048); kf[3]=*(const __attribute__((address_space(3))) bf16x8*)(kp+2560);
  kf[4]=*(const __attribute__((address_space(3))) bf16x8*)(kp+4096); kf[5]=*(const __attribute__((address_space(3))) bf16x8*)(kp+4608);
  kf[6]=*(const __attribute__((address_space(3))) bf16x8*)(kp+6144); kf[7]=*(const __attribute__((address_space(3))) bf16x8*)(kp+6656);
}
__device__ __forceinline__ void kload2(bf16x8*kf,lds_cptr kp,int j){ kf[2*j]=*(const __attribute__((address_space(3))) bf16x8*)(kp+j*2048); kf[2*j+1]=*(const __attribute__((address_space(3))) bf16x8*)(kp+j*2048+512); }
__device__ __forceinline__ s16x4 vtr(lds_cptr p){ return __builtin_bit_cast(s16x4,__builtin_amdgcn_ds_read_tr16_b64_v4i16((__attribute__((address_space(3))) v4i16_t*)p)); }
__device__ __forceinline__ float rowmax(const f32x16&p0,const f32x16&p1){
  float a=max3f(p0[0],p0[1],p1[0]),b=max3f(p0[2],p0[3],p1[1]);a=max3f(a,p1[2],p1[3]);
  #pragma unroll
  for(int r=4;r<16;r+=4){a=max3f(a,p0[r],p0[r+1]);b=max3f(b,p0[r+2],p0[r+3]);a=max3f(a,p1[r],p1[r+1]);b=max3f(b,p1[r+2],p1[r+3]);}
  const float m=max2f(a,b);
  auto rr=__builtin_amdgcn_permlane32_swap(__float_as_uint(m),__float_as_uint(m),false,false);
  return max2f(__uint_as_float(rr[0]),__uint_as_float(rr[1]));
}
__device__ __forceinline__ void pv(f32x16*o,int vb,bf16x8 pa0,bf16x8 pa1,bf16x8 pa2,bf16x8 pa3){
  #pragma unroll
  for(int d0=0;d0<2;++d0){s16x4 lo[4],hi[4];
    #pragma unroll
    for(int ks=0;ks<4;++ks){
      asm volatile("ds_read_b64_tr_b16 %0,%1 offset:%c2":"=&v"(lo[ks]):"v"(vb),"i"(d0*4096+ks*1024):"memory");
      asm volatile("ds_read_b64_tr_b16 %0,%1 offset:%c2":"=&v"(hi[ks]):"v"(vb),"i"(d0*4096+ks*1024+512):"memory");}
    asm volatile("s_waitcnt lgkmcnt(0)":::"memory");SBAR();
    #define PK(k) (bf16x8){lo[k][0],lo[k][1],lo[k][2],lo[k][3],hi[k][0],hi[k][1],hi[k][2],hi[k][3]}
    o[d0]=__builtin_amdgcn_mfma_f32_32x32x16_bf16(pa0,PK(0),o[d0],0,0,0);
    o[d0]=__builtin_amdgcn_mfma_f32_32x32x16_bf16(pa1,PK(1),o[d0],0,0,0);
    o[d0]=__builtin_amdgcn_mfma_f32_32x32x16_bf16(pa2,PK(2),o[d0],0,0,0);
    o[d0]=__builtin_amdgcn_mfma_f32_32x32x16_bf16(pa3,PK(3),o[d0],0,0,0);
    #undef PK
  }
}

__device__ __forceinline__ void pv2(f32x16*o,int vb,bf16x8 pa0,bf16x8 pa1,bf16x8 pa2,bf16x8 pa3){
  s16x4 lo[8],hi[8];
  #pragma unroll
  for(int d0=0;d0<2;++d0){
    #pragma unroll
    for(int ks=0;ks<4;++ks){
      asm volatile("ds_read_b64_tr_b16 %0,%1 offset:%c2":"=&v"(lo[d0*4+ks]):"v"(vb),"i"(d0*4096+ks*1024):"memory");
      asm volatile("ds_read_b64_tr_b16 %0,%1 offset:%c2":"=&v"(hi[d0*4+ks]):"v"(vb),"i"(d0*4096+ks*1024+512):"memory");}}
  asm volatile("s_waitcnt lgkmcnt(0)":::"memory");SBAR();
  #define PK2(k) (bf16x8){lo[k][0],lo[k][1],lo[k][2],lo[k][3],hi[k][0],hi[k][1],hi[k][2],hi[k][3]}
  o[0]=__builtin_amdgcn_mfma_f32_32x32x16_bf16(pa0,PK2(0),o[0],0,0,0); o[1]=__builtin_amdgcn_mfma_f32_32x32x16_bf16(pa0,PK2(4),o[1],0,0,0);
  o[0]=__builtin_amdgcn_mfma_f32_32x32x16_bf16(pa1,PK2(1),o[0],0,0,0); o[1]=__builtin_amdgcn_mfma_f32_32x32x16_bf16(pa1,PK2(5),o[1],0,0,0);
  o[0]=__builtin_amdgcn_mfma_f32_32x32x16_bf16(pa2,PK2(2),o[0],0,0,0); o[1]=__builtin_amdgcn_mfma_f32_32x32x16_bf16(pa2,PK2(6),o[1],0,0,0);
  o[0]=__builtin_amdgcn_mfma_f32_32x32x16_bf16(pa3,PK2(3),o[0],0,0,0); o[1]=__builtin_amdgcn_mfma_f32_32x32x16_bf16(pa3,PK2(7),o[1],0,0,0);
  #undef PK2
}

#ifndef ATTN_STORE16
#define ATTN_STORE16(p,v) (*(u32x4*)(p)=(v))
#endif
template<int THRL,bool GUARD> __device__ __forceinline__ void attn_unit(int b,int cq,int cv,int co,int qb,const bf16*Q,const bf16*__restrict__ K,const bf16*__restrict__ V,bf16*O,char*shm){
  int tid=threadIdx.x; asm volatile("":"+v"(tid)); const int lane=tid&63,r32=lane&31,hi=lane>>5; const int wid=__builtin_amdgcn_readfirstlane(tid>>6);
  const long rowbase=(long)b*SEQ; const int q0=qb*QB;
  const bf16*Qw=Q+(rowbase+q0+wid*QBLK)*PQ+cq;
  const bf16*Kh=K+rowbase*PQ+cq,*Vh=V+rowbase*PV+cv;
  const unsigned lds0=(unsigned)(uintptr_t)shm;
  float*wsf=(float*)(shm+LDS_WS)+wid*64;
  const bf16*ksrc=Kh+(long)lane*PQ+wid*8;
  const bf16*vsrc=Vh+(long)(16*(wid&3)+(lane>>2))*PV+(wid>>2)*32+(lane&3)*8;
  const unsigned kdst=lds0+LDS_K+wid*1024, vdst=lds0+LDS_V+wid*1024;
  #define DMA_K(t,slot) glds16(ksrc+(long)(t)*KVBLK*PQ,(unsigned)__builtin_amdgcn_readfirstlane(kdst+(slot)))
  #define DMA_V(t,slot) do{ glds16(vsrc+(long)(t)*KVBLK*PV,(unsigned)__builtin_amdgcn_readfirstlane(vdst+2*(slot))); glds16(vsrc+64+(long)(t)*KVBLK*PV,(unsigned)__builtin_amdgcn_readfirstlane(vdst+2*(slot)+8192)); }while(0)
  const int vb0=(int)(lds0+LDS_V)+((lane>>4)&1)*32+(lane&3)*8+(4*hi+((lane&15)>>2))*64;
  const char*Kbase=shm+LDS_K; bf16x8 kf[8];
  const lds_cptr shm3=(lds_cptr)shm; const lds_cptr kp0=shm3+LDS_K+hi*1024+r32*16; const lds_cptr vp0=shm3+LDS_V+((lane>>4)&1)*32+(lane&3)*8+(4*hi+((lane&15)>>2))*64;
  const int NT=(q0+QB)/KVBLK;
  DMA_K(0,0);DMA_V(0,0);DMA_K(1,SLOTB);
  bf16x8 qr[4];
  #pragma unroll
  for(int d0=0;d0<4;++d0)qr[d0]=*reinterpret_cast<const bf16x8*>(&Qw[(long)r32*PQ+d0*16+hi*8]);
  float mhat=0.f,l_reg=0.f;f32x16 o[4];o[0]=f32x16{};o[1]=f32x16{};o[2]=f32x16{};o[3]=f32x16{};const f32x16 zero16=f32x16{};
  const int qrel=wid*QBLK+r32;
  #define CMASK(P0,P1,t) do{int jb_=(t)-(NT-4); if(jb_>=0)cmask(P0,P1,jb_,qrel,hi);}while(0)
  bool resc=false;
  #define START(P0,P1) do{ resc=false; \
    if(GUARD){ const float rm=rowmax(P0,P1); const float dl=rm; mhat=fadd_s(mhat,dl); \
      _Pragma("unroll") for(int r=0;r<16;++r){P0[r]=fsub_s(P0[r],dl);P1[r]=fsub_s(P1[r],dl);} } \
    _Pragma("unroll") for(int r=0;r<16;++r)P0[r]=__builtin_amdgcn_exp2f(P0[r]); }while(0)
  #define RESC() do{ if(GUARD&&resc){ asm volatile("s_waitcnt lgkmcnt(0)":::"memory"); \
      _Pragma("unroll") for(int d_=0;d_<4;++d_) _Pragma("unroll") for(int r=0;r<16;++r)o[d_][r]*=wsf[crow(r,hi)]; } }while(0)
  f32x16 pA0,pA1,pB0,pB1;
  int sl_prev=0,sl_cur=0,sl_next=SLOTB;
  #define ROT() do{sl_prev=sl_cur;sl_cur=sl_next;sl_next=(sl_next==(NSLOT-1)*SLOTB)?0:sl_next+SLOTB;}while(0)
  DMA_K(2,2*SLOTB);
  WAIT_BAR(4);
  qkt(pA0,pA1,Kbase,qr,zero16,r32,hi);asm volatile("s_nop 15\n\ts_nop 7":"+v"(pA0),"+v"(pA1));CMASK(pA0,pA1,0);
  START(pA0,pA1);
  _Pragma("unroll") for(int r=0;r<16;++r)pA1[r]=__builtin_amdgcn_exp2f(pA1[r]);
  WAIT_BAR(0);
  DMA_K(3,0);DMA_V(1,SLOTB);
  ROT();
  kload8(kf,kp0+sl_cur);
  WAIT_BAR(3);
  s16x4 vlo[8],vhi[8]; u32x4 pw0,pw1,pw2,pw3;
  #define PKW(P,B) cvtpk_s(P[B],P[B+1])
  #define PAF(k) __builtin_bit_cast(bf16x8,pw##k)
  #define VFR(i) (bf16x8){vlo[i][0],vlo[i][1],vlo[i][2],vlo[i][3],vhi[i][0],vhi[i][1],vhi[i][2],vhi[i][3]}
  #define PIN(x) asm volatile("":"+v"(x))
  #define MX3(a,b,c) __builtin_fmaxf(__builtin_fmaxf((a),(b)),(c))
  #define GAPA(MF,A0,A1,A2,A3,W0,W1,PW) do{ MF; sacc+=A0; sacc+=A1; sacc+=A2; sacc+=A3; PIN(sacc); W0; W1; PIN(PW); SBAR(); }while(0)
  #define EX(v) __builtin_amdgcn_exp2f(v)
  #define GAPB(MF,X,B) do{ MF; X[B]=EX(X[B]); X[B+1]=EX(X[B+1]); X[B+2]=EX(X[B+2]); X[B+3]=EX(X[B+3]); PIN(X); SBAR(); }while(0)
  #define VRD(i) do{ vlo[i]=vtr(vp_+(((i)>>2)*4096+((i)&3)*1024)); vhi[i]=vtr(vp_+(((i)>>2)*4096+((i)&3)*1024+512)); }while(0)
  #define VRD2(i) do{ vlo[i]=vtr(vp_+(8192+((i)>>2)*4096+((i)&3)*1024)); vhi[i]=vtr(vp_+(8192+((i)>>2)*4096+((i)&3)*1024+512)); }while(0)
  #define KRD(G,j) do{ if(G){ kload2(kf,kp0+sl_next,j); SBAR(); } }while(0)
  #define STEP(C0,C1,P0,P1,t,GK,GV,GL) do{ SBAR(); \
    const lds_cptr vp_=vp0+2*sl_prev; \
    VRD(0); SBAR(); float sacc=(P0[0]+P0[1]); \
    GAPA(C0=__builtin_amdgcn_mfma_f32_32x32x16_bf16(kf[0],qr[0],zero16,0,0,0), P0[2],P0[3],P0[4],P0[5],     pw0[0]=PKW(P0,0), pw0[1]=PKW(P0,2), pw0); \
    VRD(4); SBAR(); GAPA(C1=__builtin_amdgcn_mfma_f32_32x32x16_bf16(kf[1],qr[0],zero16,0,0,0), P0[6],P0[7],P0[8],P0[9],     pw0[2]=PKW(P0,4), pw0[3]=PKW(P0,6), pw0); \
    VRD(1); SBAR(); GAPA(C0=__builtin_amdgcn_mfma_f32_32x32x16_bf16(kf[2],qr[1],C0,0,0,0),   P0[10],P0[11],P0[12],P0[13], pw1[0]=PKW(P0,8), pw1[1]=PKW(P0,10), pw1); \
    VRD(5); SBAR(); GAPA(C1=__builtin_amdgcn_mfma_f32_32x32x16_bf16(kf[3],qr[1],C1,0,0,0),   P0[14],P0[15],P1[0],P1[1],   pw1[2]=PKW(P0,12),pw1[3]=PKW(P0,14), pw1); \
    VRD(2); SBAR(); GAPA(C0=__builtin_amdgcn_mfma_f32_32x32x16_bf16(kf[4],qr[2],C0,0,0,0),   P1[2],P1[3],P1[4],P1[5],     pw2[0]=PKW(P1,0), pw2[1]=PKW(P1,2), pw2); \
    VRD(6); SBAR(); GAPA(C1=__builtin_amdgcn_mfma_f32_32x32x16_bf16(kf[5],qr[2],C1,0,0,0),   P1[6],P1[7],P1[8],P1[9],     pw2[2]=PKW(P1,4), pw2[3]=PKW(P1,6), pw2); \
    VRD(3); SBAR(); GAPA(C0=__builtin_amdgcn_mfma_f32_32x32x16_bf16(kf[6],qr[3],C0,0,0,0),   P1[10],P1[11],P1[12],P1[13], pw3[0]=PKW(P1,8), pw3[1]=PKW(P1,10), pw3); \
    VRD(7); SBAR(); GAPA(C1=__builtin_amdgcn_mfma_f32_32x32x16_bf16(kf[7],qr[3],C1,0,0,0),   P1[14],P1[15],0.f,0.f,       pw3[2]=PKW(P1,12),pw3[3]=PKW(P1,14), pw3); \
    l_reg+=sacc; \
    if(GK){DMA_K((t)+3,sl_cur);} if(GV){DMA_V((t)+1,sl_next);} \
    if(GUARD){ _Pragma("unroll") for(int r=0;r<16;++r){C0[r]-=mhat;C1[r]-=mhat;} } \
    CMASK(C0,C1,t); \
    resc=false; \
    if(GUARD){ float a=MX3(C0[0],C0[1],C1[0]),b=MX3(C0[2],C0[3],C1[1]); a=MX3(a,C1[2],C1[3]); \
      _Pragma("unroll") for(int r=4;r<16;r+=4){a=MX3(a,C0[r],C0[r+1]);b=MX3(b,C0[r+2],C0[r+3]);a=MX3(a,C1[r],C1[r+1]);b=MX3(b,C1[r+2],C1[r+3]);} \
      float rm=__builtin_fmaxf(a,b); { auto rr=__builtin_amdgcn_permlane32_swap(__float_as_uint(rm),__float_as_uint(rm),false,false); rm=__builtin_fmaxf(__uint_as_float(rr[0]),__uint_as_float(rr[1])); } \
      resc=false; \
      if(__builtin_expect(__any(rm>(float)THRL),0)){ const float dl=__builtin_fmaxf(rm,0.f); mhat+=dl; \
        _Pragma("unroll") for(int r=0;r<16;++r){C0[r]-=dl;C1[r]-=dl;} \
        const float f=__builtin_amdgcn_exp2f(-dl); l_reg*=f; if(hi==0)wsf[r32]=f; resc=true; } } \
    SBAR(); \
    GAPB(o[0]=__builtin_amdgcn_mfma_f32_32x32x16_bf16(PAF(0),VFR(0),o[0],0,0,0), C0,0); \
    GAPB(o[1]=__builtin_amdgcn_mfma_f32_32x32x16_bf16(PAF(0),VFR(4),o[1],0,0,0), C0,4); \
    KRD(GL,0); GAPB(o[0]=__builtin_amdgcn_mfma_f32_32x32x16_bf16(PAF(1),VFR(1),o[0],0,0,0), C0,8); \
    KRD(GL,1); GAPB(o[1]=__builtin_amdgcn_mfma_f32_32x32x16_bf16(PAF(1),VFR(5),o[1],0,0,0), C0,12); \
    KRD(GL,2); GAPB(o[0]=__builtin_amdgcn_mfma_f32_32x32x16_bf16(PAF(2),VFR(2),o[0],0,0,0), C1,0); \
    KRD(GL,3); GAPB(o[1]=__builtin_amdgcn_mfma_f32_32x32x16_bf16(PAF(2),VFR(6),o[1],0,0,0), C1,4); \
    GAPB(o[0]=__builtin_amdgcn_mfma_f32_32x32x16_bf16(PAF(3),VFR(3),o[0],0,0,0), C1,8); \
    GAPB(o[1]=__builtin_amdgcn_mfma_f32_32x32x16_bf16(PAF(3),VFR(7),o[1],0,0,0), C1,12); \
    pv2(o+2,vb0+2*sl_prev+8192,PAF(0),PAF(1),PAF(2),PAF(3)); \
    }while(0)
  int t=1;
  #undef CMASK
  #define CMASK(P0,P1,t) do{}while(0)
  for(;t+5<NT;t+=2){
    STEP(pB0,pB1,pA0,pA1,t,true,true,true);     WAIT_BAR(3); RESC(); ROT();
    STEP(pA0,pA1,pB0,pB1,t+1,true,true,true);   WAIT_BAR(3); RESC(); ROT();
  }
  #undef CMASK
  #define CMASK(P0,P1,t) do{int jb_=(t)-(NT-4); if(jb_>=0)cmask(P0,P1,jb_,qrel,hi);}while(0)
  #define ENDW(tt) do{ if((tt)+3<NT){WAIT_BAR(3);} else if((tt)+2<NT){WAIT_BAR(2);} else {WAIT_BAR(0);} }while(0)
  for(;t+1<NT;t+=2){
    STEP(pB0,pB1,pA0,pA1,t,(t+3<NT),(t+1<NT),(t+1<NT));       ENDW(t);   RESC(); ROT();
    STEP(pA0,pA1,pB0,pB1,t+1,(t+4<NT),(t+2<NT),(t+2<NT));     ENDW(t+1); RESC(); ROT();
  }
  STEP(pB0,pB1,pA0,pA1,NT-1,false,false,false); RESC();
  { float sacc=pB0[0]+pB0[1]; _Pragma("unroll") for(int r=2;r<16;++r)sacc+=pB0[r]; _Pragma("unroll") for(int r=0;r<16;++r)sacc+=pB1[r]; l_reg+=sacc;
    pw0=(u32x4){PKW(pB0,0),PKW(pB0,2),PKW(pB0,4),PKW(pB0,6)};pw1=(u32x4){PKW(pB0,8),PKW(pB0,10),PKW(pB0,12),PKW(pB0,14)};pw2=(u32x4){PKW(pB1,0),PKW(pB1,2),PKW(pB1,4),PKW(pB1,6)};pw3=(u32x4){PKW(pB1,8),PKW(pB1,10),PKW(pB1,12),PKW(pB1,14)};
    SBAR(); pv(o,vb0+2*sl_cur,PAF(0),PAF(1),PAF(2),PAF(3)); pv(o+2,vb0+2*sl_cur+8192,PAF(0),PAF(1),PAF(2),PAF(3)); }
  #undef PKW
  #undef PAF
  #undef VFR
  #undef PIN
  #undef MX3
  #undef GAPA
  #undef GAPB
  #undef EX
  #undef VRD
  #undef VRD2
  #undef KRD
  #undef STEP
  #undef ENDW
  {auto rr=__builtin_amdgcn_permlane32_swap(__float_as_uint(l_reg),__float_as_uint(l_reg),false,false);l_reg=__uint_as_float(rr[0])+__uint_as_float(rr[1]);}
  if(hi==0)wsf[32+r32]=l_reg;asm volatile("s_waitcnt lgkmcnt(0)":::"memory");
  float rli[16];
  #pragma unroll
  for(int r=0;r<16;++r)rli[r]=__builtin_amdgcn_rcpf(wsf[32+crow(r,hi)]);
  bf16*Ow=O+(rowbase+q0+wid*QBLK)*PO+co;
  { bf16*stg=(bf16*)(shm+LDS_OST)+wid*2048;
    int lane_e=lane; asm volatile("":"+v"(lane_e));
    #pragma unroll
    for(int half=0;half<2;++half){
      #pragma unroll
      for(int r=0;r<16;++r){const int orow=crow(r,hi);
        #pragma unroll
        for(int d0=0;d0<2;++d0)stg[orow*64+d0*32+r32]=__float2bfloat16(o[2*half+d0][r]*rli[r]);}
      asm volatile("s_waitcnt lgkmcnt(0)":::"memory");
      #pragma unroll
      for(int i=0;i<4;++i){const int row=i*8+(lane_e>>3),ch=lane_e&7; const u32x4 v=*(const u32x4*)(stg+row*64+ch*8); ATTN_STORE16(Ow+(long)row*PO+half*64+ch*8,v);}
      asm volatile("s_waitcnt lgkmcnt(0)":::"memory"); } }
  asm volatile("s_waitcnt lgkmcnt(0)\n\ts_barrier":::"memory");
  #undef DMA_K
  #undef DMA_V
  #undef CMASK
  #undef START
  #undef RESC
  #undef ROT
}
constexpr int ATTN_LDS_BYTES=LDS_BYTES;
#undef SBAR
#undef WAIT_BAR
}
#define GAS __attribute__((address_space(1)))
#define LAS __attribute__((address_space(3)))
typedef unsigned short bf16;
typedef unsigned v4u __attribute__((ext_vector_type(4)));
typedef unsigned v2u __attribute__((ext_vector_type(2)));
typedef float f32x4 __attribute__((ext_vector_type(4)));
typedef float f32x2 __attribute__((ext_vector_type(2)));
typedef short bf16x8 __attribute__((ext_vector_type(8)));

constexpr int NWAVES = 8, NTHR = 512;
constexpr int M = 16384, SEQ = 8192, DM = 1024, DPROJ = 3588, NPROJ = 3840, DMIX = 1280, DFF = 2816, DEPTH = 2;
constexpr float EPS = 1e-6f;
constexpr float C2Q = 0.125f * 1.4426950408889634f;
constexpr int M2L = 128, M2NC = SEQ / M2L;
constexpr int S5L = 128, S5NC = SEQ / S5L;
constexpr int FFN_MT = 67;

constexpr size_t MiB = 1u << 20;
constexpr size_t WS_SSQ = 0;
constexpr size_t WS_DTRAW = 1 * MiB;
constexpr size_t WS_DTV = WS_DTRAW + 256 * 1024;
constexpr size_t WS_ROPE = WS_DTV + 256 * 1024;
constexpr size_t WS_S5LB = 2 * MiB;
constexpr size_t WS_S5BB = WS_S5LB + 16 * 1024;
constexpr size_t WS_M2CD = WS_S5BB + 128 * 1024;
constexpr size_t WS_S5ST = 3 * MiB;
constexpr size_t WS_W = 4 * MiB;
constexpr size_t WS_WIN = WS_W;
constexpr size_t WS_WOUT = WS_WIN + (size_t)NPROJ * DM * 2;
constexpr size_t WS_WGU = WS_WOUT + (size_t)DM * DMIX * 2;
constexpr size_t WS_WDN = WS_WGU + (size_t)2 * DFF * DM * 2;
constexpr size_t WS_WGLU = WS_WDN + (size_t)DM * DFF * 2;
static_assert(WS_WGLU + 256 * 256 * 2 <= 32 * MiB, "weights");
constexpr size_t WS_XB = 32 * MiB + 8192;
constexpr size_t WS_MIX = 65 * MiB;
constexpr size_t WS_M2ST = 202 * MiB;
constexpr size_t WS_QK = 114 * MiB;
constexpr size_t WS_V = 146 * MiB;
constexpr size_t WS_Z = 162 * MiB;
constexpr size_t WS_SC = 170 * MiB;
constexpr size_t WS_S5U = 105 * MiB;
constexpr size_t WS_OA = 170 * MiB;
constexpr size_t WS_XBC = 202 * MiB;
constexpr size_t WS_XACT = 226 * MiB;
constexpr size_t WS_A2 = 114 * MiB;
constexpr size_t WS_RSTD = 250 * MiB + 65536;
constexpr size_t WS_CTL = 250 * MiB, CTL_BYTES = 16384;
constexpr size_t WS_END = 251 * MiB;

constexpr int LDS_BYTES = 135168;
constexpr int LDS_BARST = 131072;

__device__ __forceinline__ unsigned f2bf(float f) { unsigned u = __builtin_bit_cast(unsigned, f); return (u + 0x7fffu + ((u >> 16) & 1u)) >> 16; }
__device__ __forceinline__ unsigned pk2(float lo, float hi) { return pg8::cvt_pk_bf16(lo, hi); }
__device__ __forceinline__ float bflo(unsigned w) { return __builtin_bit_cast(float, w << 16); }
__device__ __forceinline__ float bfhi(unsigned w) { return __builtin_bit_cast(float, w & 0xffff0000u); }
__device__ __forceinline__ float bf1(bf16 h) { return __builtin_bit_cast(float, (unsigned)h << 16); }
__device__ __forceinline__ void unpack8(v4u w, float* f) { f[0] = bflo(w.x); f[1] = bfhi(w.x); f[2] = bflo(w.y); f[3] = bfhi(w.y); f[4] = bflo(w.z); f[5] = bfhi(w.z); f[6] = bflo(w.w); f[7] = bfhi(w.w); }
__device__ __forceinline__ v4u pack8(const float* f) { v4u w; w.x = pk2(f[0], f[1]); w.y = pk2(f[2], f[3]); w.z = pk2(f[4], f[5]); w.w = pk2(f[6], f[7]); return w; }
__device__ __forceinline__ float siluf(float x) { return x * __builtin_amdgcn_rcpf(1.f + __expf(-x)); }
__device__ __forceinline__ float sigmf(float x) { return __builtin_amdgcn_rcpf(1.f + __expf(-x)); }
__device__ __forceinline__ float rstd_of(const float* ssq, int row) {
    const f32x4* p = (const f32x4*)(ssq + (size_t)row * 16); f32x4 a = p[0], b = p[1], c = p[2], d = p[3];
    const float s = ((a.x + a.y) + (a.z + a.w)) + ((b.x + b.y) + (b.z + b.w)) + ((c.x + c.y) + (c.z + c.w)) + ((d.x + d.y) + (d.z + d.w));
    return rsqrtf(s * (1.f / 1024.f) + EPS);
}

struct EpiInProj {
    static constexpr bool PERM = true, AFTER_DRAIN = false, OVL = false;
    bf16 *qk, *v, *sc, *s5u, *z, *xbc; float* dtraw; const float* rstd;
    __device__ __forceinline__ void operator()(const pg8::f32x4 (&acc)[2][2][4][2], const pg8::Unit& u, int wr, int wc, int fr, int fq) const {
        const int pn = u.pn; const int row0 = u.pm * 256 + wr * 64 + fr, col0 = wc * 32 + 8 * fq; float rsv[2][4];
#pragma unroll
        for (int ai = 0; ai < 2; ++ai)
#pragma unroll
            for (int m = 0; m < 4; ++m) rsv[ai][m] = rstd[row0 + ai * 128 + m * 16];
        if (pn == 14) {
            if (wc == 0 && fq == 0) {
#pragma unroll
                for (int ai = 0; ai < 2; ++ai)
#pragma unroll
                    for (int m = 0; m < 4; ++m) *(f32x4*)(dtraw + (size_t)(row0 + ai * 128 + m * 16) * 4) = acc[ai][0][m][0] * rsv[ai][m]; }
            return; }
        bf16* base; int ld;
        if (pn < 4) { base = qk + pn * 256; ld = 1024; } else if (pn < 6) { base = v + (pn - 4) * 256; ld = 512; } else if (pn < 9) { base = sc + (pn - 6) * 256; ld = 768; }
        else if (pn == 9) { base = s5u; ld = 256; } else if (pn == 10) { base = z; ld = 256; } else { base = xbc + (pn - 11) * 256; ld = 768; }
        bf16* p0 = base + (size_t)row0 * ld + col0;
#pragma unroll
        for (int ai = 0; ai < 2; ++ai)
#pragma unroll
            for (int m = 0; m < 4; ++m) { const float rs = rsv[ai][m]; bf16* pr = p0 + (size_t)(ai * 128 + m * 16) * ld;
#pragma unroll
                for (int bj = 0; bj < 2; ++bj) { const pg8::f32x4 v0 = acc[ai][bj][m][0] * rs, v1 = acc[ai][bj][m][1] * rs; v4u w;
                    w.x = pk2(v0[0], v0[1]); w.y = pk2(v0[2], v0[3]); w.z = pk2(v1[0], v1[1]); w.w = pk2(v1[2], v1[3]);
                    *(v4u*)(pr + bj * 128) = w; } }
    }
};
template <bool RES_F32, bool OUT_F32> struct EpiResid {
    static constexpr bool PERM = true, AFTER_DRAIN = false, OVL = false;
    const float* resid; float* out; bf16* xb; float* ssq;
    __device__ __forceinline__ void operator()(const pg8::f32x4 (&acc)[2][2][4][2], const pg8::Unit& u, int wr, int wc, int fr, int fq) const {
        const int col0 = u.pn * 256 + wc * 32 + 8 * fq; const size_t off0 = (size_t)(u.pm * 256 + wr * 64 + fr) * 1024 + col0; float sq[2][4];
#pragma unroll
        for (int ai = 0; ai < 2; ++ai) {
            v4u rb[4][2]; f32x4 rf[4][2][2];
#pragma unroll
            for (int m = 0; m < 4; ++m)
#pragma unroll
                for (int bj = 0; bj < 2; ++bj) { const size_t off = off0 + (size_t)(ai * 128 + m * 16) * 1024 + bj * 128;
                    if (RES_F32) { rf[m][bj][0] = *(const f32x4*)(resid + off); rf[m][bj][1] = *(const f32x4*)(resid + off + 4); } else rb[m][bj] = *(const v4u*)(xb + off); }
#pragma unroll
            for (int m = 0; m < 4; ++m) { float s = 0.f;
#pragma unroll
                for (int bj = 0; bj < 2; ++bj) { const size_t off = off0 + (size_t)(ai * 128 + m * 16) * 1024 + bj * 128; float r[8], o[8];
                    if (RES_F32) { const f32x4 r0 = rf[m][bj][0], r1 = rf[m][bj][1]; r[0] = r0.x; r[1] = r0.y; r[2] = r0.z; r[3] = r0.w; r[4] = r1.x; r[5] = r1.y; r[6] = r1.z; r[7] = r1.w; }
                    else unpack8(rb[m][bj], r);
#pragma unroll
                    for (int j = 0; j < 8; ++j) { o[j] = r[j] + acc[ai][bj][m][j >> 2][j & 3]; s += o[j] * o[j]; }
                    if (OUT_F32) { *(f32x4*)(out + off) = (f32x4){o[0], o[1], o[2], o[3]}; *(f32x4*)(out + off + 4) = (f32x4){o[4], o[5], o[6], o[7]}; }
                    *(v4u*)(xb + off) = pack8(o); }
                sq[ai][m] = s; } }
#pragma unroll
        for (int ai = 0; ai < 2; ++ai)
#pragma unroll
            for (int m = 0; m < 4; ++m) { float s = sq[ai][m]; s += __shfl_xor(s, 16); s += __shfl_xor(s, 32);
                ssq[(size_t)(u.pm * 256 + ai * 128 + wr * 64 + m * 16 + fr) * 16 + u.pn * 4 + wc] = s; }
    }
};
struct EpiFfn1 {
    static constexpr bool PERM = true, AFTER_DRAIN = false, OVL = true;
    bf16* a2; const float* rstd; const float* cw;
    __device__ __forceinline__ void operator()(const pg8::f32x4 (&acc)[2][2][4][2], const pg8::Unit& u, int wr, int wc, int fr, int fq) const {
        const int colh = u.pn * 128 + wc * 32 + 8 * fq; const int lane = threadIdx.x & 63;
        float w0[8], w1[8], w2[8];
#pragma unroll
        for (int q = 0; q < 2; ++q) { const f32x4 a0 = *(const f32x4*)(cw + colh + 4 * q), a1 = *(const f32x4*)(cw + DFF + colh + 4 * q), a2v = *(const f32x4*)(cw + 2 * DFF + colh + 4 * q);
#pragma unroll
            for (int j = 0; j < 4; ++j) { w0[4 * q + j] = a0[j]; w1[4 * q + j] = a1[j]; w2[4 * q + j] = a2v[j]; } }
        float rsv[2][4];
#pragma unroll
        for (int ai = 0; ai < 2; ++ai)
#pragma unroll
            for (int m = 0; m < 4; ++m) { const int tok = u.pm * 248 + (2 * ai + wr) * 62 - 2 + 16 * m + fr; rsv[ai][m] = rstd[tok < 0 ? 0 : (tok > M - 1 ? M - 1 : tok)]; }
#pragma unroll
        for (int ai = 0; ai < 2; ++ai) { const int tok0 = u.pm * 248 + (2 * ai + wr) * 62 - 2;
            float p1p[8], p2p[8];
#pragma unroll
            for (int j = 0; j < 8; ++j) { p1p[j] = 0.f; p2p[j] = 0.f; }
#pragma unroll
            for (int m = 0; m < 4; ++m) { const int tok = tok0 + 16 * m + fr; const float rs = rsv[ai][m];
                float G[8], U[8], r1[8], r2[8];
#pragma unroll
                for (int j = 0; j < 4; ++j) { G[j] = acc[ai][0][m][0][j] * rs; G[4 + j] = acc[ai][0][m][1][j] * rs; U[j] = acc[ai][1][m][0][j] * rs; U[4 + j] = acc[ai][1][m][1][j] * rs; }
#pragma unroll
                for (int j = 0; j < 8; ++j) { r1[j] = __builtin_bit_cast(float, __builtin_amdgcn_update_dpp(0, __builtin_bit_cast(int, G[j]), 0x121, 0xf, 0xf, false));
                    r2[j] = __builtin_bit_cast(float, __builtin_amdgcn_update_dpp(0, __builtin_bit_cast(int, G[j]), 0x122, 0xf, 0xf, false)); }
                const int tpos = tok & (SEQ - 1); float o[8];
#pragma unroll
                for (int j = 0; j < 8; ++j) { float a1 = fr >= 1 ? r1[j] : p1p[j], b2 = fr >= 2 ? r2[j] : p2p[j]; if (tpos < 1) a1 = 0.f; if (tpos < 2) b2 = 0.f;
                    const float g = w0[j] * b2 + w1[j] * a1 + w2[j] * G[j]; o[j] = siluf(g) * U[j]; p1p[j] = r1[j]; p2p[j] = r2[j]; }
                if ((16 * m + fr) >= 2 && tok < M) *(v4u*)(a2 + (size_t)tok * DFF + colh) = pack8(o); }
        }
    }
};
struct EpiGlu {
    static constexpr bool PERM = true, AFTER_DRAIN = false, OVL = false;
    bf16* mix; const float* bias;
    __device__ __forceinline__ void operator()(const pg8::f32x4 (&acc)[2][2][4][2], const pg8::Unit& u, int wr, int wc, int fr, int fq) const {
        const int row0 = u.pm * 256 + wr * 64 + fr, col0 = wc * 32 + 8 * fq; bf16* p0 = mix + (size_t)row0 * DMIX + 768 + col0;
#pragma unroll
        for (int ai = 0; ai < 2; ++ai)
#pragma unroll
            for (int bj = 0; bj < 2; ++bj) { v4u gv[4]; const f32x4 b0 = *(const f32x4*)(bias + bj * 128 + col0), b1 = *(const f32x4*)(bias + bj * 128 + col0 + 4);
#pragma unroll
                for (int m = 0; m < 4; ++m) gv[m] = *(const v4u*)(p0 + (size_t)(ai * 128 + m * 16) * DMIX + bj * 128);
#pragma unroll
                for (int m = 0; m < 4; ++m) { float gg[8], o[8]; unpack8(gv[m], gg);
#pragma unroll
                    for (int j = 0; j < 4; ++j) { o[j] = gg[j] * sigmf(acc[ai][bj][m][0][j] + b0[j]); o[4 + j] = gg[4 + j] * sigmf(acc[ai][bj][m][1][j] + b1[j]); }
                    *(v4u*)(p0 + (size_t)(ai * 128 + m * 16) * DMIX + bj * 128) = pack8(o); } }
    }
};
struct Args { const float* in[29]; float* out; unsigned char* ws; float ropeinv[8]; int ph_lo, ph_hi; };
typedef const __attribute__((address_space(4))) Args* CArgs;
enum { I_X = 0, I_LN1G, I_WIN, I_QKG, I_DALAM, I_SUBG, I_SCW, I_S5LRE, I_S5LIM, I_S5LDT, I_S5BRE, I_S5BIM, I_S5CRE, I_S5CIM, I_S5D, I_S5WGLU, I_S5BGLU,
       I_M2CW, I_M2CB, I_M2DTB, I_M2ALOG, I_M2D, I_M2NG, I_WOUT, I_LN2G, I_WG, I_WU, I_FCW, I_WD };
#define LDS_WAIT() asm volatile("s_waitcnt lgkmcnt(0)" ::: "memory")

__device__ __forceinline__ float wave_sum(float v) {
#pragma unroll
    for (int o = 1; o < 64; o <<= 1) v += __shfl_xor(v, o);
    return v;
}
__device__ __forceinline__ void sincos_f(float a, float& s, float& c) {
    const float n = __builtin_rintf(a * 0.6366197723675814f);
    float r = __builtin_fmaf(-n, 1.5703125f, a); r = __builtin_fmaf(-n, 4.837512969970703125e-4f, r); r = __builtin_fmaf(-n, 7.54978995489188216e-8f, r);
    const int q = (int)n & 3; const float r2 = r * r;
    const float sp = r + r * r2 * (-1.6666654611e-1f + r2 * (8.3321608736e-3f + r2 * (-1.9515295891e-4f)));
    const float cp = 1.0f - 0.5f * r2 + r2 * r2 * (4.166664568298827e-2f + r2 * (-1.388731625493765e-3f + r2 * 2.443315711809948e-5f));
    s = (q == 0) ? sp : (q == 1) ? cp : (q == 2) ? -sp : -cp;
    c = (q == 0) ? cp : (q == 1) ? -sp : (q == 2) ? -cp : sp;
}

__device__ __forceinline__ void tr_item(const float* W, int K, int N, int Npad, bf16* WT, const float* scale, int mode, LAS float* scr, int item, int lane) {
    const int nblk = Npad / 32, kb = item / nblk, nb = item % nblk, k0 = 64 * kb, n0 = 32 * nb;
    const int n4 = n0 + (lane & 7) * 4;
#pragma unroll
    for (int i = 0; i < 8; ++i) { const int kk = 8 * i + (lane >> 3); f32x4 v = (n4 < N) ? __builtin_nontemporal_load((const f32x4*)(W + (size_t)(k0 + kk) * N + n4)) : (f32x4){0.f, 0.f, 0.f, 0.f}; if (scale) v = v * scale[k0 + kk];
        LAS float* d = scr + kk * 33 + (lane & 7) * 4; d[0] = v.x; d[1] = v.y; d[2] = v.z; d[3] = v.w; }
    LDS_WAIT();
    const int c = lane & 7;
#pragma unroll
    for (int j = 0; j < 4; ++j) { const int nl = (lane >> 3) + 8 * j; const LAS float* s = scr + (8 * c) * 33 + nl;
        v4u o; o.x = pk2(s[0 * 33], s[1 * 33]); o.y = pk2(s[2 * 33], s[3 * 33]); o.z = pk2(s[4 * 33], s[5 * 33]); o.w = pk2(s[6 * 33], s[7 * 33]);
        const int nn = n0 + nl; const int row = (mode == 0) ? nn : (256 * (nn >> 7) + (nn & 127) + (mode == 2 ? 128 : 0));
        *(v4u*)(WT + (size_t)row * K + k0 + 8 * c) = o; }
    LDS_WAIT();
}

__device__ __forceinline__ void rstd_reduce(CArgs a, int gtid, int NT) {
    const float* ssq = (const float*)(a->ws + WS_SSQ); float* r = (float*)(a->ws + WS_RSTD);
    for (int row = gtid; row < M; row += NT) r[row] = rstd_of(ssq, row);
}
template <int REP> __device__ __forceinline__ void p0_convert(CArgs a, int l, LAS unsigned char* lds, int gw, int NGW, int gtid, int NT, int wave, int lane) {
    unsigned char* ws = a->ws;
    LAS float* scr = (LAS float*)(lds + wave * 8704);
    constexpr int I_IN = (DM / 64) * (NPROJ / 32), I_OUT = (DMIX / 64) * (DM / 32), I_G = (DM / 64) * (DFF / 32), I_D = (DFF / 64) * (DM / 32), I_GLU = (256 / 64) * (256 / 32);
    constexpr int NIT = I_IN + I_OUT + 2 * I_G + I_D + I_GLU;
    for (int it = gw; it < NIT; it += NGW) { int r = it;
        if (r < I_IN) { tr_item(a->in[I_WIN] + (size_t)l * DM * DPROJ, DM, DPROJ, NPROJ, (bf16*)(ws + WS_WIN), a->in[I_LN1G] + l * DM, 0, scr, r, lane); continue; } r -= I_IN;
        if (r < I_OUT) { tr_item(a->in[I_WOUT] + (size_t)l * DMIX * DM, DMIX, DM, DM, (bf16*)(ws + WS_WOUT), nullptr, 0, scr, r, lane); continue; } r -= I_OUT;
        if (r < I_G) { tr_item(a->in[I_WG] + (size_t)l * DM * DFF, DM, DFF, DFF, (bf16*)(ws + WS_WGU), a->in[I_LN2G] + l * DM, 1, scr, r, lane); continue; } r -= I_G;
        if (r < I_G) { tr_item(a->in[I_WU] + (size_t)l * DM * DFF, DM, DFF, DFF, (bf16*)(ws + WS_WGU), a->in[I_LN2G] + l * DM, 2, scr, r, lane); continue; } r -= I_G;
        if (r < I_D) { tr_item(a->in[I_WD] + (size_t)l * DFF * DM, DFF, DM, DM, (bf16*)(ws + WS_WDN), nullptr, 0, scr, r, lane); continue; } r -= I_D;
        tr_item(a->in[I_S5WGLU] + (size_t)l * 65536, 256, 256, 256, (bf16*)(ws + WS_WGLU), nullptr, 0, scr, r, lane);
    }
    if constexpr (REP == 1) return;
    for (int idx = gtid; idx < 1024; idx += NT) { const int g = idx >> 6;
        const float lr = a->in[I_S5LRE][l * 1024 + idx], li = a->in[I_S5LIM][l * 1024 + idx], dt = __expf(a->in[I_S5LDT][l * 16 + g]);
        float s, c; sincos_f(li * dt, s, c); const float mg = __expf(lr * dt); const float br = mg * c, bi = mg * s;
        float sL, cL; sincos_f(li * dt * (float)S5L, sL, cL); const float mL = __expf(lr * dt * (float)S5L);
        ((f32x4*)(ws + WS_S5LB))[idx] = (f32x4){br, bi, mL * cL, mL * sL};
        const float d2 = lr * lr + li * li, cr = ((br - 1.0f) * lr + bi * li) / d2, ci = (bi * lr - (br - 1.0f) * li) / d2;
        const f32x4* brp = (const f32x4*)(a->in[I_S5BRE] + ((size_t)l * 1024 + idx) * 16); const f32x4* bip = (const f32x4*)(a->in[I_S5BIM] + ((size_t)l * 1024 + idx) * 16);
        float xr[16], xi[16];
#pragma unroll
        for (int q = 0; q < 4; ++q) { const f32x4 vr = brp[q], vi = bip[q]; xr[4 * q] = vr.x; xr[4 * q + 1] = vr.y; xr[4 * q + 2] = vr.z; xr[4 * q + 3] = vr.w; xi[4 * q] = vi.x; xi[4 * q + 1] = vi.y; xi[4 * q + 2] = vi.z; xi[4 * q + 3] = vi.w; }
        { const int p = idx & 63, ct = p >> 3; v2u* bf = (v2u*)(ws + WS_S5BB) + ((size_t)(g * 8 + ct) * 64);
#pragma unroll
          for (int fq = 0; fq < 4; ++fq) { float br4[4], bi4[4];
#pragma unroll
              for (int jj = 0; jj < 4; ++jj) { const int hh = 4 * fq + jj; br4[jj] = cr * xr[hh] - ci * xi[hh]; bi4[jj] = cr * xi[hh] + ci * xr[hh]; }
              v2u wr_, wi_; wr_.x = pk2(br4[0], br4[1]); wr_.y = pk2(br4[2], br4[3]); wi_.x = pk2(bi4[0], bi4[1]); wi_.y = pk2(bi4[2], bi4[3]);
              bf[fq * 16 + 2 * (p & 7)] = wr_; bf[fq * 16 + 2 * (p & 7) + 1] = wi_; } }
    }
    if (l != 0) rstd_reduce(a, gtid, NT);
    if (l == 0) {
        const float* x = a->in[I_X]; bf16* XB = (bf16*)(ws + WS_XB); float* rstdp = (float*)(ws + WS_RSTD);
        for (int m0 = gw * 2; m0 < M; m0 += NGW * 2) { f32x4 v[2][4];
#pragma unroll
            for (int rr = 0; rr < 2; ++rr)
#pragma unroll
                for (int j = 0; j < 4; ++j) v[rr][j] = ((const f32x4*)(x + (size_t)(m0 + rr) * DM) + lane)[64 * j];
#pragma unroll
            for (int rr = 0; rr < 2; ++rr) { const int m = m0 + rr; v2u* o = (v2u*)(XB + (size_t)m * DM) + lane; float s = 0.f;
#pragma unroll
                for (int j = 0; j < 4; ++j) { const f32x4 t = v[rr][j]; s += (t.x * t.x + t.y * t.y) + (t.z * t.z + t.w * t.w); v2u w; w.x = pk2(t.x, t.y); w.y = pk2(t.z, t.w); o[64 * j] = w; }
                s = wave_sum(s); if (lane == 0) rstdp[m] = rsqrtf(s * (1.f / 1024.f) + EPS); } }
        float* rope = (float*)(ws + WS_ROPE);
        for (int idx = gtid; idx < SEQ * 8; idx += NT) { const int pos = idx >> 3, i = idx & 7; const float inv = (i == 0) ? a->ropeinv[0] : (i == 1) ? a->ropeinv[1] : (i == 2) ? a->ropeinv[2] : (i == 3) ? a->ropeinv[3] : (i == 4) ? a->ropeinv[4] : (i == 5) ? a->ropeinv[5] : (i == 6) ? a->ropeinv[6] : a->ropeinv[7]; const float ang = (float)pos * inv; float s, c; sincos_f(ang, s, c);
            rope[pos * 16 + i] = c; rope[pos * 16 + 8 + i] = s; }
    }
}

template <int REP> __device__ __forceinline__ void p2_prep(CArgs a, int l, int gw, int NGW, int gtid, int NT, int lane) {
    unsigned char* ws = a->ws;
    if constexpr (REP == 0) { bf16* QK = (bf16*)(ws + WS_QK); const float* rope = (const float*)(ws + WS_ROPE); const int isk = lane >> 5, quarter = lane & 3;
      const float* gq = a->in[I_QKG] + l * 128 + isk * 64 + quarter * 16; float gg[16];
#pragma unroll
      for (int j = 0; j < 16; ++j) gg[j] = gq[j] * (isk ? 1.f : C2Q);
      for (int tk = gw * 4; tk < M; tk += NGW * 4) { v4u rw[4][2]; f32x4 cs4[4][4];
#pragma unroll
          for (int rr = 0; rr < 4; ++rr) { const v4u* row = (const v4u*)(QK + (size_t)(tk + rr) * 1024 + lane * 16); rw[rr][0] = row[0]; rw[rr][1] = row[1];
              const f32x4* cs = (const f32x4*)(rope + ((tk + rr) & (SEQ - 1)) * 16);
#pragma unroll
              for (int q = 0; q < 4; ++q) cs4[rr][q] = cs[q]; }
#pragma unroll
          for (int rr = 0; rr < 4; ++rr) { v4u* row = (v4u*)(QK + (size_t)(tk + rr) * 1024 + lane * 16); float f[16]; unpack8(rw[rr][0], f); unpack8(rw[rr][1], f + 8); float ss = 0.f;
#pragma unroll
              for (int j = 0; j < 16; ++j) ss += f[j] * f[j];
              ss += __shfl_xor(ss, 1); ss += __shfl_xor(ss, 2); const float rs = rsqrtf(ss * (1.f / 64.f) + EPS);
#pragma unroll
              for (int j = 0; j < 16; ++j) f[j] = f[j] * rs * gg[j];
#pragma unroll
              for (int i = 0; i < 8; ++i) { const float c = (quarter == 0) ? cs4[rr][i >> 2][i & 3] : 1.f, s = (quarter == 0) ? cs4[rr][2 + (i >> 2)][i & 3] : 0.f, x1 = f[i], x2 = f[8 + i]; f[i] = x1 * c - x2 * s; f[8 + i] = x1 * s + x2 * c; }
              row[0] = pack8(f); row[1] = pack8(f + 8); } } }
    { const bf16* SC = (const bf16*)(ws + WS_SC); bf16* MIX = (bf16*)(ws + WS_MIX); const float* cw = a->in[I_SCW] + l * 768;
      for (int it = gtid; it < 32 * (M / 4); it += NT) { const int ch = (it & 31) * 8, t0 = (it >> 5) * 4; float w0[8], w1[8], w2[8], p1[8], p2[8];
#pragma unroll
          for (int j = 0; j < 8; ++j) { w0[j] = cw[ch + j]; w1[j] = cw[256 + ch + j]; w2[j] = cw[512 + ch + j]; p1[j] = 0.f; p2[j] = 0.f; }
          const bool first = (t0 & (SEQ - 1)) == 0; const bf16* r0 = SC + (size_t)t0 * 768 + ch;
          v4u pc[2], ph[2], vb[4], vc[4], vh[4];
#pragma unroll
          for (int u = 0; u < 2; ++u) { pc[u] = first ? (v4u){0u, 0u, 0u, 0u} : *(const v4u*)(r0 + (u - 2) * 768 + 256); ph[u] = first ? (v4u){0u, 0u, 0u, 0u} : *(const v4u*)(r0 + (u - 2) * 768 + 512); }
#pragma unroll
          for (int u = 0; u < 4; ++u) { vb[u] = *(const v4u*)(r0 + u * 768); vc[u] = *(const v4u*)(r0 + u * 768 + 256); vh[u] = *(const v4u*)(r0 + u * 768 + 512); }
          { float c8[8], h8[8]; unpack8(pc[0], c8); unpack8(ph[0], h8);
#pragma unroll
            for (int j = 0; j < 8; ++j) p2[j] = c8[j] * h8[j];
            unpack8(pc[1], c8); unpack8(ph[1], h8);
#pragma unroll
            for (int j = 0; j < 8; ++j) p1[j] = c8[j] * h8[j]; }
#pragma unroll
          for (int u = 0; u < 4; ++u) { float b8[8], c8[8], h8[8], o[8]; unpack8(vb[u], b8); unpack8(vc[u], c8); unpack8(vh[u], h8);
#pragma unroll
              for (int j = 0; j < 8; ++j) { const float p0 = c8[j] * h8[j]; o[j] = b8[j] * (w0[j] * p2[j] + w1[j] * p1[j] + w2[j] * p0); p2[j] = p1[j]; p1[j] = p0; }
              *(v4u*)(MIX + (size_t)(t0 + u) * DMIX + 512 + ch) = pack8(o); } } }
    { const bf16* XBC = (const bf16*)(ws + WS_XBC); bf16* XA = (bf16*)(ws + WS_XACT); const float* cw = a->in[I_M2CW] + l * 4 * 768; const float* cb = a->in[I_M2CB] + l * 768;
      for (int it = gtid; it < 32 * (M / 4); it += NT) { const int t0 = (it >> 5) * 4; const bool first = (t0 & (SEQ - 1)) == 0;
#pragma unroll
          for (int g3 = 0; g3 < 3; ++g3) { const int ch = ((it & 31) + 32 * g3) * 8; float w0[8], w1[8], w2[8], w3[8], bb[8], x1[8], x2[8], x3[8];
#pragma unroll
              for (int j = 0; j < 8; ++j) { w0[j] = cw[ch + j]; w1[j] = cw[768 + ch + j]; w2[j] = cw[1536 + ch + j]; w3[j] = cw[2304 + ch + j]; bb[j] = cb[ch + j]; x1[j] = 0.f; x2[j] = 0.f; x3[j] = 0.f; }
              v4u xv[7];
#pragma unroll
              for (int u = 0; u < 7; ++u) xv[u] = (first && u < 3) ? (v4u){0u, 0u, 0u, 0u} : *(const v4u*)(XBC + (size_t)(t0 - 3 + u) * 768 + ch);
              unpack8(xv[0], x3); unpack8(xv[1], x2); unpack8(xv[2], x1);
#pragma unroll
              for (int u = 0; u < 4; ++u) { float x0[8], o[8]; unpack8(xv[3 + u], x0);
#pragma unroll
                  for (int j = 0; j < 8; ++j) { o[j] = siluf(bb[j] + w0[j] * x3[j] + w1[j] * x2[j] + w2[j] * x1[j] + w3[j] * x0[j]); x3[j] = x2[j]; x2[j] = x1[j]; x1[j] = x0[j]; }
                  *(v4u*)(XA + (size_t)(t0 + u) * 768 + ch) = pack8(o); } } } }
    { const float* dr = (const float*)(ws + WS_DTRAW); float* dv = (float*)(ws + WS_DTV); const float* db = a->in[I_M2DTB] + l * 4;
      for (int idx = gtid; idx < M * 4; idx += NT) { const float x = dr[idx] + db[idx & 3]; dv[idx] = (x > 20.f) ? x : __logf(1.f + __expf(x)); } }
}

typedef short s16x4v __attribute__((ext_vector_type(4)));
template <bool OUT> __device__ __forceinline__ void s5_pass(CArgs a, int l, LAS unsigned char* lds, int gw, int NGW, int wave, int lane) {
    unsigned char* ws = a->ws; const bf16* S5U = (const bf16*)(ws + WS_S5U); bf16* MIX = (bf16*)(ws + WS_MIX); f32x2* ST = (f32x2*)(ws + WS_S5ST);
    LAS bf16* Ub = (LAS bf16*)(lds + wave * 16384); LAS float* BUt = (LAS float*)(lds + wave * 16384 + 4096); LAS unsigned* Xt = (LAS unsigned*)(lds + wave * 16384 + 12288); LAS bf16* Yt = (LAS bf16*)(lds + wave * 16384 + 4096);
    const int fr = lane & 15, fq = lane >> 4;
    for (int unit = gw; unit < 2 * 16 * S5NC; unit += NGW) { const int c = unit % S5NC, g = (unit / S5NC) % 16, b = unit / (S5NC * 16); const int tok0 = b * SEQ + c * S5L;
#pragma unroll
        for (int r = 0; r < 2; ++r) { const int t = lane + 64 * r; const v4u* src = (const v4u*)(S5U + (size_t)(tok0 + t) * 256 + g * 16); const v4u u0 = src[0], u1 = src[1];
            *(LAS v4u*)(Ub + t * 16) = u0; *(LAS v4u*)(Ub + t * 16 + 8) = u1; }
        const f32x4 lb = ((const f32x4*)(ws + WS_S5LB))[g * 64 + lane]; s16x4v Bf[8];
#pragma unroll
        for (int ct = 0; ct < 8; ++ct) Bf[ct] = ((const s16x4v*)(ws + WS_S5BB))[(size_t)(g * 8 + ct) * 64 + lane];
        const f32x2 la = {lb.x, lb.x}, lbm = {-lb.y, lb.y};
        float xr = 0.f, xi = 0.f; bf16x8 Cf[4]; float dsk = 0.f;
        if (OUT) {
            const f32x2* stp = ST + ((size_t)(b * 16 + g) * S5NC) * 64 + lane;
            { const f32x2 s = stp[c * 64]; xr = s.x; xi = s.y; }
            const float* cre = a->in[I_S5CRE] + ((size_t)(l * 16 + g) * 16 + fr) * 64; const float* cim = a->in[I_S5CIM] + ((size_t)(l * 16 + g) * 16 + fr) * 64;
#pragma unroll
            for (int kk = 0; kk < 4; ++kk)
#pragma unroll
                for (int j = 0; j < 8; ++j) { const int k = 32 * kk + 8 * fq + j, p = k >> 1; const float v = (k & 1) ? -cim[p] : cre[p]; Cf[kk][j] = (short)f2bf(v); }
            dsk = a->in[I_S5D][l * 256 + g * 16 + fr];
        }
        LDS_WAIT();
        for (int t0 = 0; t0 < S5L; t0 += 16) {
            { const s16x4v av = *(const LAS s16x4v*)(Ub + (t0 + fr) * 16 + 4 * fq);
#pragma unroll
              for (int ct = 0; ct < 8; ++ct) { pg8::f32x4 acc = {0.f, 0.f, 0.f, 0.f}; acc = __builtin_amdgcn_mfma_f32_16x16x16bf16_1k(av, Bf[ct], acc, 0, 0, 0);
#pragma unroll
                  for (int i = 0; i < 4; ++i) BUt[(4 * fq + i) * 128 + 16 * ct + fr] = acc[i]; } }
            LDS_WAIT();
#pragma unroll 4
            for (int tt = 0; tt < 16; ++tt) { const f32x2 bu = *(const LAS f32x2*)(BUt + tt * 128 + 2 * lane);
                { const f32x2 xs = {xi, xr}; f32x2 xn = __builtin_elementwise_fma(la, (f32x2){xr, xi}, bu); xn = __builtin_elementwise_fma(lbm, xs, xn); xr = xn.x; xi = xn.y; }
                if (OUT) Xt[tt * 64 + lane] = pk2(xr, xi); }
            if (OUT) { LDS_WAIT(); pg8::f32x4 acc = {0.f, 0.f, 0.f, 0.f};
#pragma unroll
                for (int kk = 0; kk < 4; ++kk) { const bf16x8 av = *(const LAS bf16x8*)((const LAS unsigned char*)Xt + fr * 256 + (32 * kk + 8 * fq) * 2); acc = __builtin_amdgcn_mfma_f32_16x16x32_bf16(av, Cf[kk], acc, 0, 0, 0); }
#pragma unroll
                for (int i = 0; i < 4; ++i) { const int t = t0 + 4 * fq + i; const float y = acc[i] + dsk * bf1(Ub[t * 16 + fr]); const float zz = 0.7978845608028654f * (y + 0.044715f * y * y * y);
                    const float gl = y * __builtin_amdgcn_rcpf(1.f + __expf(-2.f * zz)); Yt[(4 * fq + i) * 16 + fr] = (bf16)f2bf(gl); }
                LDS_WAIT();
                if (lane < 32) { const v4u v = *(const LAS v4u*)(Yt + (lane >> 1) * 16 + (lane & 1) * 8); *(v4u*)(MIX + (size_t)(tok0 + t0 + (lane >> 1)) * DMIX + 768 + g * 16 + (lane & 1) * 8) = v; }
                LDS_WAIT(); }
            else LDS_WAIT();
        }
        if (!OUT) ST[((size_t)(b * 16 + g) * S5NC + c) * 64 + lane] = (f32x2){xr, xi};
        LDS_WAIT();
    }
}

constexpr int M2P = 136;
template <bool OUT> __device__ __forceinline__ void m2_pass(CArgs a, int l, LAS unsigned char* lds, int tid) {
    unsigned char* ws = a->ws; const bf16* XA = (const bf16*)(ws + WS_XACT); const float* dtv = (const float*)(ws + WS_DTV); float* ST = (float*)(ws + WS_M2ST); float* CD = (float*)(ws + WS_M2CD); bf16* MIX = (bf16*)(ws + WS_MIX);
    const int lane = tid & 63, wave = __builtin_amdgcn_readfirstlane(tid >> 6), fr = lane & 15, fq = lane >> 4;
    LAS bf16* R0 = (LAS bf16*)lds;
    LAS bf16* R1 = (LAS bf16*)(lds + 34816);
    LAS bf16* XT = (LAS bf16*)(lds + 69632);
    LAS bf16* Hs = (LAS bf16*)(lds + 87040);
    LAS float* csl = (LAS float*)(lds + 104448); LAS float* dtl = csl + 128;
    for (int unit = blockIdx.x; unit < 2 * 4 * M2NC; unit += gridDim.x) { const int c = unit % M2NC, h = (unit / M2NC) & 3, b = unit / (M2NC * 4), grp = h >> 1; const int tok0 = b * SEQ + c * M2L;
        const float A = -__expf(a->in[I_M2ALOG][l * 4 + h]), Dh = a->in[I_M2D][l * 4 + h];
        float* stu = ST + (size_t)unit * 8192;
        const bf16* prow = XA + (size_t)(tok0 + (tid >> 2)) * 768; const int pq = tid & 3;
        const v4u px0 = *(const v4u*)(prow + h * 64 + 16 * pq), px1 = *(const v4u*)(prow + h * 64 + 16 * pq + 8); v4u pb[4], pc[4];
#pragma unroll
        for (int u = 0; u < 4; ++u) { pb[u] = ((const v4u*)(prow + 256 + grp * 128 + 32 * pq))[u]; if (OUT) pc[u] = ((const v4u*)(prow + 512 + grp * 128 + 32 * pq))[u]; }
        __syncthreads();
        if (wave == 0) { const float d0 = dtv[(tok0 + 2 * lane) * 4 + h], d1 = dtv[(tok0 + 2 * lane + 1) * 4 + h]; const float v0 = A * d0, v1 = v0 + A * d1; float p = v1;
#pragma unroll
            for (int o = 1; o < 64; o <<= 1) { const float t = __shfl_up(p, o); if (lane >= o) p += t; }
            const float ex = p - v1; csl[2 * lane] = ex + v0; csl[2 * lane + 1] = ex + v1; dtl[2 * lane] = d0; dtl[2 * lane + 1] = d1; }
        __syncthreads();
        { const int t = tid >> 2, q = tid & 3; const float dtt = dtl[t];
          float xf[16]; unpack8(px0, xf); unpack8(px1, xf + 8);
          const float sc = OUT ? dtt : dtt * __expf(csl[127] - csl[t]);
          LAS bf16* xdst = OUT ? XT : R1;
#pragma unroll
          for (int j = 0; j < 16; ++j) xdst[(16 * q + j) * M2P + t] = (bf16)f2bf(xf[j] * sc);
          const v4u* bsrc = pb;
          if (OUT) { const v4u* csrc = pc;
#pragma unroll
              for (int u = 0; u < 4; ++u) { *(LAS v4u*)(R1 + t * M2P + 32 * q + 8 * u) = bsrc[u]; *(LAS v4u*)(R0 + t * M2P + 32 * q + 8 * u) = csrc[u]; } }
          else {
#pragma unroll
              for (int u = 0; u < 4; ++u) { const v4u w = bsrc[u]; const unsigned ww[4] = {w.x, w.y, w.z, w.w};
#pragma unroll
                  for (int j = 0; j < 4; ++j) { R0[(32 * q + 8 * u + 2 * j) * M2P + t] = (bf16)(ww[j] & 0xffffu); R0[(32 * q + 8 * u + 2 * j + 1) * M2P + t] = (bf16)(ww[j] >> 16); } } }
        }
        if (OUT) { const int p = tid >> 3, n0 = (tid & 7) * 16; const f32x4* src = (const f32x4*)(stu + p * 128 + n0); float hv[16];
#pragma unroll
            for (int u = 0; u < 4; ++u) { const f32x4 v = src[u]; hv[4 * u] = v.x; hv[4 * u + 1] = v.y; hv[4 * u + 2] = v.z; hv[4 * u + 3] = v.w; }
            *(LAS v4u*)(Hs + p * M2P + n0) = pack8(hv); *(LAS v4u*)(Hs + p * M2P + n0 + 8) = pack8(hv + 8); }
        __syncthreads();
        if (!OUT) { const int pt = wave >> 1, nt0 = (wave & 1) * 4; bf16x8 af[4];
#pragma unroll
            for (int kk = 0; kk < 4; ++kk) af[kk] = *(const LAS bf16x8*)(R1 + (16 * pt + fr) * M2P + 32 * kk + 8 * fq);
#pragma unroll
            for (int nt = 0; nt < 4; ++nt) { pg8::f32x4 acc = {0.f, 0.f, 0.f, 0.f};
#pragma unroll
                for (int kk = 0; kk < 4; ++kk) { const bf16x8 bfv = *(const LAS bf16x8*)(R0 + (16 * (nt0 + nt) + fr) * M2P + 32 * kk + 8 * fq); acc = __builtin_amdgcn_mfma_f32_16x16x32_bf16(af[kk], bfv, acc, 0, 0, 0); }
#pragma unroll
                for (int i = 0; i < 4; ++i) stu[(16 * pt + 4 * fq + i) * 128 + 16 * (nt0 + nt) + fr] = acc[i]; }
            if (tid == 0) CD[unit] = __expf(csl[127]);
        } else {
            bf16x8 aC[4];
#pragma unroll
            for (int kk = 0; kk < 4; ++kk) aC[kk] = *(const LAS bf16x8*)(R0 + (16 * wave + fr) * M2P + 32 * kk + 8 * fq);
            float csi[4];
#pragma unroll
            for (int i = 0; i < 4; ++i) csi[i] = csl[16 * wave + 4 * fq + i];
            float sc[8][4];
#pragma unroll
            for (int j = 0; j < 8; ++j) { pg8::f32x4 acc = {0.f, 0.f, 0.f, 0.f};
                if (j <= wave) {
#pragma unroll
                    for (int kk = 0; kk < 4; ++kk) { const bf16x8 bfv = *(const LAS bf16x8*)(R1 + (16 * j + fr) * M2P + 32 * kk + 8 * fq); acc = __builtin_amdgcn_mfma_f32_16x16x32_bf16(aC[kk], bfv, acc, 0, 0, 0); } }
                const int s = 16 * j + fr; const float css = csl[s];
#pragma unroll
                for (int i = 0; i < 4; ++i) { const int l_ = 16 * wave + 4 * fq + i; sc[j][i] = (s <= l_) ? acc[i] * __expf(csi[i] - css) : 0.f; } }
            pg8::f32x4 y[4];
#pragma unroll
            for (int pt = 0; pt < 4; ++pt) { pg8::f32x4 acc = {0.f, 0.f, 0.f, 0.f};
#pragma unroll
                for (int kk = 0; kk < 4; ++kk) { const bf16x8 bfv = *(const LAS bf16x8*)(Hs + (16 * pt + fr) * M2P + 32 * kk + 8 * fq); acc = __builtin_amdgcn_mfma_f32_16x16x32_bf16(aC[kk], bfv, acc, 0, 0, 0); }
#pragma unroll
                for (int i = 0; i < 4; ++i) acc[i] *= __expf(csi[i]);
                y[pt] = acc; }
            __syncthreads();
#pragma unroll
            for (int j = 0; j < 8; ++j)
#pragma unroll
                for (int i = 0; i < 4; ++i) R1[(16 * wave + 4 * fq + i) * M2P + 16 * j + fr] = (bf16)f2bf(sc[j][i]);
            LDS_WAIT();
#pragma unroll
            for (int kk = 0; kk < 4; ++kk) { if (32 * kk <= 16 * wave + 15) { const bf16x8 aS = *(const LAS bf16x8*)(R1 + (16 * wave + fr) * M2P + 32 * kk + 8 * fq);
#pragma unroll
                    for (int pt = 0; pt < 4; ++pt) { const bf16x8 bfv = *(const LAS bf16x8*)(XT + (16 * pt + fr) * M2P + 32 * kk + 8 * fq); y[pt] = __builtin_amdgcn_mfma_f32_16x16x32_bf16(aS, bfv, y[pt], 0, 0, 0); } } }
#pragma unroll
            for (int i = 0; i < 4; ++i) { const int l_ = 16 * wave + 4 * fq + i; const float rdt = Dh / dtl[l_];
#pragma unroll
                for (int pt = 0; pt < 4; ++pt) { const int p = 16 * pt + fr; const float yy = y[pt][i] + rdt * bf1(XT[p * M2P + l_]); R0[l_ * 72 + p] = (bf16)f2bf(yy); } }
            LDS_WAIT();
#pragma unroll
            for (int u = 0; u < 2; ++u) { const int rr = 16 * wave + (lane >> 2), ch = (lane & 3) * 2 + u; const v4u v = *(const LAS v4u*)(R0 + rr * 72 + ch * 8);
                *(v4u*)(MIX + (size_t)(tok0 + rr) * DMIX + 1024 + h * 64 + ch * 8) = v; }
        }
    }
    __syncthreads();
}
__device__ __forceinline__ void m2_carry(CArgs a, int gtid, int NT) {
    float* ST = (float*)(a->ws + WS_M2ST); const float* CD = (const float*)(a->ws + WS_M2CD);
    for (int idx = gtid; idx < 2 * 4 * 64 * 128; idx += NT) { const int bh = idx >> 13, e = idx & 8191; float* p = ST + (size_t)bh * M2NC * 8192 + e; const float* cd = CD + bh * M2NC; float hc = 0.f;
        for (int c0 = 0; c0 < M2NC; c0 += 32) { float t[32], d[32];
#pragma unroll
            for (int u = 0; u < 32; ++u) { t[u] = p[(size_t)(c0 + u) * 8192]; d[u] = cd[c0 + u]; }
#pragma unroll
            for (int u = 0; u < 32; ++u) { p[(size_t)(c0 + u) * 8192] = hc; hc = d[u] * hc + t[u]; } } }
    f32x2* S5 = (f32x2*)(a->ws + WS_S5ST); const f32x4* LB = (const f32x4*)(a->ws + WS_S5LB);
    for (int idx = NT - 1 - gtid; idx < 2048; idx += NT) { const int bg = idx >> 6, p = idx & 63; const f32x4 lb = LB[(bg & 15) * 64 + p]; f32x2* sp = S5 + (size_t)bg * S5NC * 64 + p; float xr = 0.f, xi = 0.f;
        for (int c0 = 0; c0 < S5NC; c0 += 32) { f32x2 t[32];
#pragma unroll
            for (int u = 0; u < 32; ++u) t[u] = sp[(c0 + u) * 64];
#pragma unroll
            for (int u = 0; u < 32; ++u) { sp[(c0 + u) * 64] = (f32x2){xr, xi}; const float nr = lb.z * xr - lb.w * xi + t[u].x, ni = lb.z * xi + lb.w * xr + t[u].y; xr = nr; xi = ni; } } }
}

template <int REP> __device__ __forceinline__ void p7_combine(CArgs a, int l, int gw, int NGW, int lane) {
    unsigned char* ws = a->ws; const bf16* OA = (const bf16*)(ws + WS_OA); bf16* MIX = (bf16*)(ws + WS_MIX); const bf16* Z = (const bf16*)(ws + WS_Z);
    const float linit = (l == 0) ? 0.2f : 0.35550906759096927f;
    const float* lp = a->in[I_DALAM] + l * 256;
    const float s1 = wave_sum(lp[lane] * lp[64 + lane]), s2 = wave_sum(lp[128 + lane] * lp[192 + lane]); const float lam = __expf(s1) - __expf(s2) + linit, osc = 1.f - linit;
    const int h = lane >> 4, e0 = (lane & 15) * 8, vh = e0 >> 6, d0 = e0 & 63; float sg[8], ng[4];
#pragma unroll
    for (int j = 0; j < 8; ++j) sg[j] = a->in[I_SUBG][l * 128 + e0 + j] * osc;
#pragma unroll
    for (int j = 0; j < 4; ++j) ng[j] = a->in[I_M2NG][l * 256 + lane * 4 + j];
    for (int tk = gw * 4; tk < M; tk += NGW * 4) {
        v4u q0[4], q1[4]; v2u yw[4], zw[4];
#pragma unroll
        for (int rr = 0; rr < 4; ++rr) { const int tok = tk + rr; const bf16* o = OA + (size_t)tok * 1024 + h * 256 + vh * 64 + d0; q0[rr] = *(const v4u*)o; q1[rr] = *(const v4u*)(o + 128);
            if constexpr (REP == 0) { yw[rr] = *(const v2u*)(MIX + (size_t)tok * DMIX + 1024 + lane * 4); zw[rr] = *(const v2u*)(Z + (size_t)tok * 256 + lane * 4); } }
#pragma unroll
        for (int rr = 0; rr < 4; ++rr) { const int tok = tk + rr;
        { float p0[8], p1[8], f[8]; unpack8(q0[rr], p0); unpack8(q1[rr], p1); float ss = 0.f;
#pragma unroll
          for (int j = 0; j < 8; ++j) { f[j] = p0[j] - lam * p1[j]; ss += f[j] * f[j]; }
          ss += __shfl_xor(ss, 1); ss += __shfl_xor(ss, 2); ss += __shfl_xor(ss, 4); ss += __shfl_xor(ss, 8); const float rs = rsqrtf(ss * (1.f / 128.f) + EPS);
#pragma unroll
          for (int j = 0; j < 8; ++j) f[j] = f[j] * rs * sg[j];
          *(v4u*)(MIX + (size_t)tok * DMIX + h * 128 + e0) = pack8(f); }
        if constexpr (REP == 0) { v2u* yp = (v2u*)(MIX + (size_t)tok * DMIX + 1024 + lane * 4); const v2u y2 = yw[rr], z2 = zw[rr];
          float v[4] = {bflo(y2.x) * siluf(bflo(z2.x)), bfhi(y2.x) * siluf(bfhi(z2.x)), bflo(y2.y) * siluf(bflo(z2.y)), bfhi(y2.y) * siluf(bfhi(z2.y))};
          const float ss = wave_sum((v[0] * v[0] + v[1] * v[1]) + (v[2] * v[2] + v[3] * v[3])); const float rs = rsqrtf(ss * (1.f / 256.f) + EPS);
          v2u w; w.x = pk2(v[0] * rs * ng[0], v[1] * rs * ng[1]); w.y = pk2(v[2] * rs * ng[2], v[3] * rs * ng[3]); *yp = w; } }
    }
}
typedef GAS unsigned gu32;
#define XB_TMO      128
#define XB_XCNT(j)  (256  + 64 * (j))
#define XB_XSUB(j)  (1280 + 64 * (j))
#define XB_XGEN(j)  (2304 + 64 * (j))
#define XB_TOP      3328
#define XB_TOPGEN   3392
#define XCD_BAR_WORDS 3456
#define XB_SPIN_CAP (1u << 18)

__device__ __forceinline__ unsigned xb_ld(unsigned* p)              { return __hip_atomic_load(p, __ATOMIC_RELAXED, __HIP_MEMORY_SCOPE_AGENT); }
__device__ __forceinline__ unsigned xb_add(unsigned* p, unsigned v) { return __hip_atomic_fetch_add(p, v, __ATOMIC_RELAXED, __HIP_MEMORY_SCOPE_AGENT); }
__device__ __forceinline__ unsigned xb_xcc_id() { return (unsigned)__builtin_amdgcn_s_getreg((3 << 11) | 20) & 0xFu; }
#define XB_SPIN(cond, bar) do { unsigned _sp = 0; while (cond) { __builtin_amdgcn_s_sleep(1); \
    if ((++_sp & 255u) == 0u) { if (xb_ld(&(bar)[XB_TMO])) break; if (_sp > XB_SPIN_CAP) { atomicAdd(&(bar)[XB_TMO], 1u); break; } } } } while (0)

struct XcdBarrier {
    unsigned* bar; unsigned x;
    volatile LAS unsigned* st;
};

__device__ __forceinline__ XcdBarrier xcd_barrier_post(unsigned* bar, volatile LAS unsigned* st) {
    XcdBarrier b; b.bar = bar; b.x = xb_xcc_id(); b.st = st;
    if (threadIdx.x == 0) (void)xb_add(&bar[XB_XCNT(b.x)], 1u);
    return b;
}
__device__ __forceinline__ void xcd_barrier_complete(unsigned* bar, unsigned x, unsigned& nloc, unsigned& nx) {
    const unsigned G = gridDim.x * gridDim.y * gridDim.z;
    unsigned sum, cnt, mine, sp = 0u;
    for (;;) {
        sum = 0u; cnt = 0u; mine = 0u;
#pragma unroll
        for (unsigned j = 0; j < 16; ++j) { const unsigned c = xb_ld(&bar[XB_XCNT(j)]); sum += c; cnt += (c > 0u) ? 1u : 0u; mine = (j == x) ? c : mine; }
        if (sum == G) break;
        __builtin_amdgcn_s_sleep(1);
        if ((++sp & 255u) == 0u) { if (xb_ld(&bar[XB_TMO])) break; if (sp > XB_SPIN_CAP) { atomicAdd(&bar[XB_TMO], 1u); break; } }
    }
    nloc = mine > 0u ? mine : 1u; nx = cnt > 0u ? cnt : 1u;
}

__device__ __forceinline__ void xcd_barrier(const XcdBarrier& b) {
    asm volatile("s_waitcnt vmcnt(0)" ::: "memory");
    __syncthreads();
    if (threadIdx.x == 0) {
        unsigned* bar = b.bar;
        __builtin_amdgcn_s_waitcnt(0);
        unsigned nloc = b.st[0], nx = b.st[1];
        if (nloc == 0u) { xcd_barrier_complete(bar, b.x, nloc, nx); b.st[0] = nloc; b.st[1] = nx; }
        const unsigned old = xb_add(&bar[XB_XSUB(b.x)], 1u);
        const unsigned gen = old / nloc;
        if (old + 1u == (gen + 1u) * nloc) {
            __builtin_amdgcn_fence(__ATOMIC_RELEASE, "agent");
            asm volatile("s_waitcnt vmcnt(0)" ::: "memory");
            const unsigned og = xb_add(&bar[XB_TOP], 1u);
            const unsigned tg = og / nx;
            if (og + 1u == (tg + 1u) * nx) xb_add(&bar[XB_TOPGEN], 1u);
            else XB_SPIN(xb_ld(&bar[XB_TOPGEN]) == tg, bar);
            __builtin_amdgcn_fence(__ATOMIC_ACQUIRE, "agent");
            xb_add(&bar[XB_XGEN(b.x)], 1u);
            asm volatile("s_waitcnt vmcnt(0)" ::: "memory");
        } else {
            XB_SPIN(xb_ld(&bar[XB_XGEN(b.x)]) == gen, bar);
            __builtin_amdgcn_fence(__ATOMIC_ACQUIRE, "agent");
            asm volatile("s_waitcnt vmcnt(0)" ::: "memory");
        }
    }
    __syncthreads();
}

constexpr int NPH = 11 * DEPTH;
#ifndef PHMASK
#define PHMASK 0x7ff
#endif
#define PHM(k) ((PHMASK >> (k)) & 1)
#ifndef DUPMASK
#define DUPMASK 0
#endif
template <int PH, int REP = 0> __device__ __forceinline__ void run_phase(CArgs a0, unsigned char* lds_raw) {
    LAS unsigned char* lds = (LAS unsigned char*)lds_raw;
        constexpr int l = PH / 11, k = PH % 11;
        int G_ = gridDim.x, bx_ = blockIdx.x; asm volatile("" : "+s"(G_), "+s"(bx_)); const int G = G_, bx = bx_; const int vcu = (G % 8 == 0) ? (bx % 8) * (G / 8) + bx / 8 : bx;
        const int NGW = G * NWAVES, NT = G * NTHR;
        int tid_ = threadIdx.x; asm volatile("" : "+v"(tid_)); const int tid = tid_, lane = tid & 63, wave = __builtin_amdgcn_readfirstlane(tid >> 6);
        const int gw = bx * NWAVES + wave, gtid = bx * NTHR + tid;
        CArgs a = a0; asm volatile("" : "+s"(a)); unsigned char* ws = a->ws;
        bf16* XB = (bf16*)(ws + WS_XB); float* ssq = (float*)(ws + WS_SSQ); bf16* MIX = (bf16*)(ws + WS_MIX);
        if constexpr (k == 0 && PHM(0)) { p0_convert<REP>(a, l, lds, gw, NGW, gtid, NT, wave, lane); }
        else if constexpr (k == 1 && PHM(1)) {
            pg8::Gemm g{XB, (const bf16*)(ws + WS_WIN), M, NPROJ, DM, DM}; pg8::StaticOrder S; S.init(M, NPROJ, G, bx);
            EpiInProj E{(bf16*)(ws + WS_QK), (bf16*)(ws + WS_V), (bf16*)(ws + WS_SC), (bf16*)(ws + WS_S5U), (bf16*)(ws + WS_Z), (bf16*)(ws + WS_XBC), (float*)(ws + WS_DTRAW), (const float*)(ws + WS_RSTD)};
            pg8::gemm_phase<EpiInProj, pg8::StaticOrder, true, true>(lds, g, S, E);
        }
        else if constexpr (k == 2 && PHM(2)) { p2_prep<REP>(a, l, gw, NGW, gtid, NT, lane); s5_pass<false>(a, l, lds, gw, NGW, wave, lane); }
        else if constexpr (k == 3 && PHM(3)) { m2_pass<false>(a, l, lds, tid); }
        else if constexpr (k == 4 && PHM(4)) { m2_carry(a, gtid, NT); }
        else if constexpr (k == 5 && PHM(5)) { m2_pass<true>(a, l, lds, tid); s5_pass<true>(a, l, lds, gw, NGW, wave, lane); __syncthreads();
            const attn_body::bf16* QK = (const attn_body::bf16*)(ws + WS_QK);
            bool nomax; { float gq = __builtin_fabsf(a->in[I_QKG][l * 128 + lane]), gk = __builtin_fabsf(a->in[I_QKG][l * 128 + 64 + lane]);
#pragma unroll
                for (int o = 1; o < 64; o <<= 1) { gq = __builtin_fmaxf(gq, __shfl_xor(gq, o)); gk = __builtin_fmaxf(gk, __shfl_xor(gk, o)); }
                nomax = __builtin_amdgcn_readfirstlane((11.55f * gq * gk < 64.f) ? 1 : 0) != 0; }
            for (int q = vcu; q < 256; q += G) { const int bhc = q >> 4, s = q & 15, b = bhc >> 3, hd = (bhc >> 1) & 3, cc = bhc & 1;
                for (int i = 0; i < 2; ++i) { const int qb = (i == 0) ? s : 31 - s;
                    if (nomax) attn_body::attn_unit<8, false>(b, hd * 128 + cc * 64, hd * 128, hd * 256 + cc * 128, qb, QK, QK + 512, (const attn_body::bf16*)(ws + WS_V), (attn_body::bf16*)(ws + WS_OA), (char*)lds_raw);
                    else attn_body::attn_unit<8, true>(b, hd * 128 + cc * 64, hd * 128, hd * 256 + cc * 128, qb, QK, QK + 512, (const attn_body::bf16*)(ws + WS_V), (attn_body::bf16*)(ws + WS_OA), (char*)lds_raw); } }
        }
        else if constexpr (k == 6 && PHM(6)) {
            { constexpr int NGLU = M / 256;
              if (G > 2 * NGLU) { if (bx >= NGLU) p7_combine<REP>(a, l, (bx - NGLU) * NWAVES + wave, (G - NGLU) * NWAVES, lane); }
              else p7_combine<REP>(a, l, gw, NGW, lane); }
            if constexpr (REP == 0) {
            pg8::Gemm g{MIX + 768, (const bf16*)(ws + WS_WGLU), M, 256, 256, DMIX}; pg8::StaticOrder S; S.init(M, 256, G, bx);
            EpiGlu E{MIX, a->in[I_S5BGLU] + l * 256};
            pg8::gemm_phase<EpiGlu, pg8::StaticOrder, true, true>(lds, g, S, E); }
        }
        else if constexpr (k == 8 && PHM(8)) { rstd_reduce(a, gtid, NT); }
        else if constexpr (k == 7 && PHM(7)) {
            pg8::Gemm g{MIX, (const bf16*)(ws + WS_WOUT), M, DM, DMIX, DMIX}; pg8::StaticOrder S; S.init(M, DM, G, bx);
            typedef EpiResid<(l == 0), false> EpiR; EpiR E{a->in[I_X], a->out, XB, ssq};
            pg8::gemm_phase<EpiR, pg8::StaticOrder, true, true>(lds, g, S, E);
        }
        else if constexpr (k == 9 && PHM(9)) {
            pg8::Gemm g{XB - 2 * DM, (const bf16*)(ws + WS_WGU), FFN_MT * 256, 2 * DFF, DM, DM}; pg8::StaticOrder S; S.init(FFN_MT * 256, 2 * DFF, G, bx);
            EpiFfn1 E{(bf16*)(ws + WS_A2), (const float*)(ws + WS_RSTD), a->in[I_FCW] + l * 3 * DFF};
            pg8::gemm_phase<EpiFfn1, pg8::StaticOrder, true, true>(lds, g, S, E);
        }
        else if constexpr (k == 10 && PHM(10)) {
            pg8::Gemm g{(const bf16*)(ws + WS_A2), (const bf16*)(ws + WS_WDN), M, DM, DFF, DFF}; pg8::StaticOrder S; S.init(M, DM, G, bx);
            typedef EpiResid<false, (l == DEPTH - 1)> EpiR; EpiR E{nullptr, a->out, XB, ssq};
            pg8::gemm_phase<EpiR, pg8::StaticOrder, true, true>(lds, g, S, E);
        }
}
__global__ void __launch_bounds__(NTHR, 2) fwd_kernel(Args a_unused) {
    extern __shared__ __attribute__((aligned(16))) unsigned char lds_raw[];
    CArgs a0 = (CArgs)__builtin_amdgcn_kernarg_segment_ptr(); const int ph_lo = a0->ph_lo, ph_hi = a0->ph_hi;
    { volatile LAS unsigned* st = (volatile LAS unsigned*)((LAS unsigned char*)lds_raw + LDS_BARST); if (threadIdx.x < 2) st[threadIdx.x] = 0u; __syncthreads();
      if (ph_hi - ph_lo > 1) {
          unsigned* ctl = (unsigned*)(a0->ws + WS_CTL);
          if (blockIdx.x == 0) { const int t = threadIdx.x;
              if (t < 51) { const int w = t < 16 ? XB_XCNT(t) : t < 32 ? XB_XSUB(t - 16) : t < 48 ? XB_XGEN(t - 32) : t == 48 ? XB_TMO : t == 49 ? XB_TOP : XB_TOPGEN; __hip_atomic_store(ctl + w, 0u, __ATOMIC_RELAXED, __HIP_MEMORY_SCOPE_AGENT); }
              asm volatile("s_waitcnt vmcnt(0)" ::: "memory"); }
          cg::this_grid().sync();
          (void)xcd_barrier_post(ctl, st); } }
#define SEAM(P) do { { CArgs ab = a0; asm volatile("" : "+s"(ab)); XcdBarrier bar; bar.bar = (unsigned*)(ab->ws + WS_CTL); bar.x = xb_xcc_id(); bar.st = (volatile LAS unsigned*)((LAS unsigned char*)lds_raw + LDS_BARST); xcd_barrier(bar); } } while (0)
#define RUNPH(P) if (ph_lo <= (P) && (P) < ph_hi) { run_phase<(P)>(a0, lds_raw); if constexpr ((DUPMASK >> ((P) % 11)) & 1) { SEAM(P); run_phase<(P), 1>(a0, lds_raw); } if ((P) + 1 < ph_hi) SEAM(P); }
    RUNPH(0) RUNPH(1) RUNPH(2) RUNPH(3) RUNPH(4) RUNPH(5) RUNPH(6) RUNPH(7) RUNPH(8) RUNPH(9) RUNPH(10)
    RUNPH(11) RUNPH(12) RUNPH(13) RUNPH(14) RUNPH(15) RUNPH(16) RUNPH(17) RUNPH(18) RUNPH(19) RUNPH(20) RUNPH(21)
#undef RUNPH
#undef SEAM
}

#ifndef ONE_LAUNCH
#define ONE_LAUNCH 1
#endif
extern "C" void kernel_launch(void* const* d_in, const int* in_sizes, int n_in, void* d_out, int out_size, void* d_ws, size_t ws_size, hipStream_t stream) {
    static int grid = 0;
    if (grid == 0) {
        if (n_in != 29 || out_size != M * DM || ws_size < WS_END) { fprintf(stderr, "kernel_launch: unexpected problem (n_in %d, out %d, ws %zu)\n", n_in, out_size, ws_size); grid = -1; return; }
        int dev = 0, cus = 0, per_cu = 0;
        if (hipGetDevice(&dev) != hipSuccess || hipDeviceGetAttribute(&cus, hipDeviceAttributeMultiprocessorCount, dev) != hipSuccess) { grid = -1; return; }
        if (hipFuncSetAttribute((const void*)fwd_kernel, hipFuncAttributeMaxDynamicSharedMemorySize, LDS_BYTES) != hipSuccess) { fprintf(stderr, "kernel_launch: hipFuncSetAttribute failed\n"); grid = -1; return; }
        if (hipOccupancyMaxActiveBlocksPerMultiprocessor(&per_cu, (const void*)fwd_kernel, NTHR, LDS_BYTES) != hipSuccess || per_cu < 1) { fprintf(stderr, "kernel_launch: occupancy query says %d\n", per_cu); (void)hipGetLastError(); grid = -1; return; }
        grid = cus * 1;
    }
    if (grid < 0) return;
    Args a{};
    for (int i = 0; i < 29; ++i) a.in[i] = (const float*)d_in[i];
    a.out = (float*)d_out; a.ws = (unsigned char*)d_ws;
    for (int i = 0; i < 8; ++i) { const float e = (float)(2 * i) / 16.0f; const float pw = powf(500000.0f, e); a.ropeinv[i] = 1.0f / pw; }
#if ONE_LAUNCH
    a.ph_lo = 0; a.ph_hi = NPH;
    void* args[] = {&a};
    hipError_t e = hipLaunchCooperativeKernel((const void*)fwd_kernel, dim3(grid), dim3(NTHR), args, LDS_BYTES, stream);
    if (e != hipSuccess) fprintf(stderr, "cooperative launch failed: %s (grid %d)\n", hipGetErrorString(e), grid);
#else
    for (int ph = 0; ph < NPH; ++ph) { a.ph_lo = ph; a.ph_hi = ph + 1; hipLaunchKernelGGL(fwd_kernel, dim3(grid), dim3(NTHR), LDS_BYTES, stream, a); }
#endif
}
```

```cpp
#include <hip/hip_runtime.h>
#include <hip/hip_cooperative_groups.h>
#include <cstdio>
#include <cstdint>
namespace cg = cooperative_groups;
namespace pg8 {
#define PG8_LAS __attribute__((address_space(3)))
typedef unsigned short bf16_t;
typedef short bf16x8 __attribute__((ext_vector_type(8)));
typedef float f32x4 __attribute__((ext_vector_type(4)));
typedef unsigned u32x4 __attribute__((ext_vector_type(4)));
constexpr int BM = 256, BK = 64, HALF = 128, HTB = HALF * BK * 2  , STAGE_BYTES = 8 * HTB, NXCD = 8, WGM = 8;

__host__ __device__ __forceinline__ int lds_byte(int r, int c) { const int st = (r >> 4) * 2 + (c >> 5), rr = r & 15, cc = c & 31, ob = rr * 64 + cc * 2; return st * 1024 + (ob ^ (((ob >> 9) & 1) << 5)); }
__host__ __device__ __forceinline__ void stage_rc(int b, int& R, int& C) { const int st = b / 1024, sb = b % 1024, swz = sb ^ (((sb >> 9) & 1) << 5); R = (st >> 1) * 16 + swz / 64; C = (st & 1) * 32 + (swz % 64) / 2; }
__host__ __device__ __forceinline__ int perm32(int rho) { const int n = rho >> 4, i = rho & 15; return 8 * (i >> 2) + 4 * n + (i & 3); }

struct Unit { int pm, pn; };
struct Gemm { const bf16_t* A; const bf16_t* Bt; int M, N, K, lda; };

struct StaticOrder {
    int nM, nN, nwg, G, c;
    __host__ __device__ void init(int M, int N, int G_, int c_) { nM = M / BM; nN = N / BM; nwg = nM * nN; G = G_; c = c_; }
    __host__ __device__ bool next(int i, Unit& u) const {
        const long L = (long)i * G + c; if (L >= nwg) return false;
        int wgid = (int)L; { const int q = nwg / NXCD, r = nwg % NXCD, xcd = wgid % NXCD, off = wgid / NXCD; wgid = (xcd < r ? xcd * (q + 1) : r * (q + 1) + (xcd - r) * q) + off; }
        const int nig = WGM * nN, gid = wgid / nig, fm = gid * WGM, gsz = (nM - fm) < WGM ? (nM - fm) : WGM;
        u.pm = fm + ((wgid % nig) % gsz); u.pn = (wgid % nig) / gsz; return true;
    }
    __device__ __forceinline__ void a_ready(const Unit&) const {}
    __device__ __forceinline__ void done(const Unit&) const {}
};

__device__ __forceinline__ unsigned cvt_pk_bf16(float lo, float hi) { unsigned r; asm volatile("v_cvt_pk_bf16_f32 %0, %1, %2" : "=v"(r) : "v"(lo), "v"(hi)); return r; }
template <class Epi, class Sched, bool ALIGN_EPI = false, bool SP2 = false>
__device__ __forceinline__ void gemm_phase(PG8_LAS unsigned char* lds, const Gemm g, const Sched& S, const Epi& E) {
    int tid_ = threadIdx.x; asm volatile("" : "+v"(tid_)); const int tid = tid_, wid = __builtin_amdgcn_readfirstlane(tid >> 6), lane = tid & 63, wr = wid >> 2, wc = wid & 3, fr = lane & 15, fq = lane >> 4;
    const int K = g.K, nt = K / BK;
    unsigned voffA[2], voffB[2];
#pragma unroll
    for (int i = 0; i < 2; ++i) { int R, C; stage_rc(tid * 16 + i * 8192, R, C); const int Rb = Epi::PERM ? ((R & ~31) + perm32(R & 31)) : R;
        const int Ra = Epi::OVL ? (R - 2 * (R >> 6)) : R; voffA[i] = (unsigned)(Ra * g.lda + C) * 2u; voffB[i] = (unsigned)(Rb * K + C) * 2u; }
    const size_t kstep = (size_t)(BK * 2);
    const size_t hstepB = (size_t)HALF * K * 2, tstepB = 2 * hstepB;
    const size_t hstepA = (size_t)(Epi::OVL ? 124 : HALF) * g.lda * 2, tstepA = 2 * hstepA;
    const unsigned ldsw = (unsigned)wid * 1024u;
    const int aoff = lds_byte(wr * 64 + fr, fq * 8), boff = lds_byte(wc * 32 + fr, fq * 8);
#define PG8_SA(b, h) (((b) * 2 + (h)) * HTB)
#define PG8_SB(b, h) ((4 + (b) * 2 + (h)) * HTB)
#define PG8_STAGE(bufoff, gbase, voff) do { _Pragma("unroll") for (int _i = 0; _i < 2; ++_i) \
        __builtin_amdgcn_global_load_lds((const unsigned*)((const char*)(gbase) + (voff)[_i]), (PG8_LAS unsigned*)(lds + (bufoff) + ldsw + _i * 8192), 16, 0, 0); } while (0)
#define PG8_LDA(dst, b, h) do { _Pragma("unroll") for (int m = 0; m < 4; ++m) _Pragma("unroll") for (int k = 0; k < 2; ++k) dst[m][k] = *(const PG8_LAS bf16x8*)(lds + PG8_SA(b, h) + aoff + m * 2048 + k * 1024); } while (0)
#define PG8_LDB(dst, b, h) do { _Pragma("unroll") for (int n = 0; n < 2; ++n) _Pragma("unroll") for (int k = 0; k < 2; ++k) dst[n][k] = *(const PG8_LAS bf16x8*)(lds + PG8_SB(b, h) + boff + n * 2048 + k * 1024); } while (0)
#define PG8_MMA(ai, bj, At, Bt) do { __builtin_amdgcn_s_setprio(1); _Pragma("unroll") for (int m = 0; m < 4; ++m) _Pragma("unroll") for (int n = 0; n < 2; ++n) _Pragma("unroll") for (int k = 0; k < 2; ++k) \
        acc[ai][bj][m][n] = __builtin_amdgcn_mfma_f32_16x16x32_bf16(Bt[n][k], At[m][k], acc[ai][bj][m][n], 0, 0, 0); __builtin_amdgcn_s_setprio(0); } while (0)
#define PG8_WAIT_V(n) asm volatile("s_waitcnt vmcnt(" #n ")" ::: "memory")
#define PG8_WAIT_L(n) asm volatile("s_waitcnt lgkmcnt(" #n ")" ::: "memory")
#define PG8_BAR __builtin_amdgcn_s_barrier()
#define PG8_SCHED __builtin_amdgcn_sched_barrier(0)
    Unit cur, nxt; int ui = 0;
    if (!S.next(0, cur)) return;
    f32x4 acc[2][2][4][2];
#pragma unroll
    for (int a = 0; a < 2; ++a)
#pragma unroll
        for (int b = 0; b < 2; ++b)
#pragma unroll
            for (int m = 0; m < 4; ++m)
#pragma unroll
                for (int n = 0; n < 2; ++n) acc[a][b][m][n] = (f32x4){0.f, 0.f, 0.f, 0.f};
    bf16x8 At[4][2], B0[2][2], B1[2][2];
    const char* cA = (const char*)g.A + (size_t)cur.pm * tstepA; const char* cB = (const char*)g.Bt + (size_t)cur.pn * tstepB;
    S.a_ready(cur);
    if constexpr (SP2) {
        PG8_STAGE(PG8_SB(0, 0), cB, voffB); PG8_STAGE(PG8_SB(0, 1), cB + hstepB, voffB); PG8_STAGE(PG8_SA(0, 0), cA, voffA); PG8_STAGE(PG8_SA(0, 1), cA + hstepA, voffA);
        if (wr == 1) PG8_BAR;
        PG8_WAIT_V(2); PG8_BAR;
        PG8_STAGE(PG8_SB(1, 0), cB + kstep, voffB); PG8_STAGE(PG8_SA(1, 0), cA + kstep, voffA); PG8_STAGE(PG8_SB(1, 1), cB + hstepB + kstep, voffB);
        PG8_WAIT_V(6); PG8_BAR;
    } else {
        PG8_STAGE(PG8_SB(0, 0), cB, voffB); PG8_STAGE(PG8_SA(0, 0), cA, voffA); PG8_STAGE(PG8_SB(0, 1), cB + hstepB, voffB); PG8_STAGE(PG8_SA(0, 1), cA + hstepA, voffA);
        if (wr == 1) PG8_BAR;
        PG8_WAIT_V(4); PG8_BAR;
        PG8_STAGE(PG8_SB(1, 0), cB + kstep, voffB); PG8_STAGE(PG8_SA(1, 0), cA + kstep, voffA); PG8_STAGE(PG8_SB(1, 1), cB + hstepB + kstep, voffB);
        PG8_WAIT_V(6); PG8_BAR;
    }
    for (;;) {
        const bool has_next = S.next(ui + 1, nxt);
        const char* nA = has_next ? (const char*)g.A + (size_t)nxt.pm * tstepA : cA; const char* nB = has_next ? (const char*)g.Bt + (size_t)nxt.pn * tstepB : cB;
        for (int t = 0; t < nt; t += 2) {
            const bool last = (t == nt - 2);
            const char* a1 = cA + (size_t)(t + 1) * kstep;
            const char* a2 = last ? nA : cA + (size_t)(t + 2) * kstep; const char* b2 = last ? nB : cB + (size_t)(t + 2) * kstep;
            const char* a3 = a2 + kstep; const char* b3 = b2 + kstep;
            if (last && has_next) S.a_ready(nxt);
            if constexpr (SP2) {
            PG8_LDB(B0, 0, 0); PG8_LDB(B1, 0, 1); PG8_SCHED; PG8_LDA(At, 0, 0); PG8_STAGE(PG8_SA(1, 1), a1 + hstepA, voffA);
            PG8_WAIT_V(8); PG8_WAIT_L(0); PG8_BAR; PG8_MMA(0, 0, At, B0); PG8_MMA(0, 1, At, B1); PG8_BAR; PG8_SCHED;
            PG8_LDA(At, 0, 1); PG8_STAGE(PG8_SB(0, 0), b2, voffB); PG8_STAGE(PG8_SB(0, 1), b2 + hstepB, voffB); PG8_STAGE(PG8_SA(0, 0), a2, voffA);
            PG8_WAIT_V(8); PG8_WAIT_L(0); PG8_BAR; PG8_MMA(1, 0, At, B0); PG8_MMA(1, 1, At, B1); PG8_BAR; PG8_SCHED;
            PG8_LDB(B0, 1, 0); PG8_LDB(B1, 1, 1); PG8_SCHED; PG8_LDA(At, 1, 0); PG8_STAGE(PG8_SA(0, 1), a2 + hstepA, voffA);
            PG8_WAIT_V(8); PG8_WAIT_L(0); PG8_BAR; PG8_MMA(0, 0, At, B0); PG8_MMA(0, 1, At, B1); PG8_BAR; PG8_SCHED;
            PG8_LDA(At, 1, 1); PG8_STAGE(PG8_SB(1, 0), b3, voffB); PG8_STAGE(PG8_SB(1, 1), b3 + hstepB, voffB); PG8_STAGE(PG8_SA(1, 0), a3, voffA);
            PG8_WAIT_V(8); PG8_WAIT_L(0); PG8_BAR; PG8_MMA(1, 0, At, B0); PG8_MMA(1, 1, At, B1); PG8_BAR; PG8_SCHED;
            } else {
            PG8_LDB(B0, 0, 0); PG8_SCHED; PG8_LDA(At, 0, 0); PG8_STAGE(PG8_SA(1, 1), a1 + hstepA, voffA);
            PG8_WAIT_L(8); PG8_BAR; PG8_WAIT_L(0); PG8_MMA(0, 0, At, B0); PG8_BAR; PG8_SCHED;
            PG8_LDB(B1, 0, 1); PG8_STAGE(PG8_SB(0, 0), b2, voffB);
            PG8_BAR; PG8_WAIT_L(0); PG8_MMA(0, 1, At, B1); PG8_BAR;
            PG8_LDA(At, 0, 1); PG8_STAGE(PG8_SA(0, 0), a2, voffA);
            PG8_BAR; PG8_WAIT_L(0); PG8_MMA(1, 0, At, B0); PG8_BAR; PG8_SCHED;
            PG8_STAGE(PG8_SB(0, 1), b2 + hstepB, voffB);
            PG8_WAIT_V(6); PG8_BAR; PG8_MMA(1, 1, At, B1); PG8_BAR;
            PG8_LDB(B0, 1, 0); PG8_SCHED; PG8_LDA(At, 1, 0); PG8_STAGE(PG8_SA(0, 1), a2 + hstepA, voffA);
            PG8_WAIT_L(8); PG8_BAR; PG8_WAIT_L(0); PG8_MMA(0, 0, At, B0); PG8_BAR; PG8_SCHED;
            PG8_LDB(B1, 1, 1); PG8_STAGE(PG8_SB(1, 0), b3, voffB);
            PG8_BAR; PG8_WAIT_L(0); PG8_MMA(0, 1, At, B1); PG8_BAR;
            PG8_LDA(At, 1, 1); PG8_STAGE(PG8_SA(1, 0), a3, voffA);
            PG8_BAR; PG8_WAIT_L(0); PG8_MMA(1, 0, At, B0); PG8_BAR; PG8_SCHED;
            PG8_STAGE(PG8_SB(1, 1), b3 + hstepB, voffB);
            PG8_WAIT_V(6); PG8_BAR; PG8_MMA(1, 1, At, B1); PG8_BAR;
            }
        }
        if constexpr (ALIGN_EPI) { if (wr == 0) PG8_BAR; }
        if constexpr (!Epi::AFTER_DRAIN) { E(acc, cur, wr, wc, fr, fq); S.done(cur); }
        if (!has_next) break;
#pragma unroll
        for (int a = 0; a < 2; ++a)
#pragma unroll
            for (int b = 0; b < 2; ++b)
#pragma unroll
                for (int m = 0; m < 4; ++m)
#pragma unroll
                    for (int n = 0; n < 2; ++n) acc[a][b][m][n] = (f32x4){0.f, 0.f, 0.f, 0.f};
        cur = nxt; cA = nA; cB = nB; ++ui;
        if constexpr (ALIGN_EPI) { if (wr == 1) PG8_BAR; }
    }
    PG8_WAIT_V(0);
    if constexpr (!ALIGN_EPI) { if (wr == 0) PG8_BAR; }
    PG8_BAR;
    if constexpr (Epi::AFTER_DRAIN) { E.fused(acc, cur, wr, wc, fr, fq, lds, wid, lane); S.done(cur); }
#undef PG8_SA
#undef PG8_SB
#undef PG8_STAGE
#undef PG8_LDA
#undef PG8_LDB
#undef PG8_MMA
#undef PG8_WAIT_V
#undef PG8_WAIT_L
#undef PG8_BAR
#undef PG8_SCHED
}
}
#include <hip/hip_bf16.h>
#include <cmath>
namespace attn_body {
using bf16=__hip_bfloat16;
using bf16x8=__attribute__((ext_vector_type(8)))short;
using s16x4=__attribute__((ext_vector_type(4)))short;
using f32x16=__attribute__((ext_vector_type(16)))float;
using u32x4=__attribute__((ext_vector_type(4)))unsigned;
constexpr int BATCH=2,NHEAD=16,SEQ=8192,D=64,PQ=1024,PV=512,PO=1024;
constexpr int NW=8,QBLK=32,QB=QBLK*NW,KVBLK=64,NQB=SEQ/QB;
constexpr int ATTN_UNIT_ROWS=QB;
__device__ __forceinline__ int crow(int r,int hi){return (r&3)+8*(r>>2)+4*hi;}
#define SBAR() __builtin_amdgcn_sched_barrier(0)
__device__ __forceinline__ void cmask(f32x16&p0,f32x16&p1,int jb,int qrel,int hi){
  const float NEG=-INFINITY; int kb=64*jb+4*hi;
  #pragma unroll
  for(int r=0;r<16;++r){int kv=kb+(r&3)+8*(r>>2); if(kv>qrel)p0[r]=NEG; if(kv+32>qrel)p1[r]=NEG;}
}

constexpr int NSLOT=3, SLOTB=8192;
constexpr int LDS_K=0, LDS_V=NSLOT*SLOTB, LDS_WS=3*NSLOT*SLOTB, LDS_OST=LDS_WS+NW*64*4, LDS_BYTES=LDS_OST+NW*4096;
constexpr float C2=0.125f*1.4426950408889634f;
__device__ __forceinline__ void glds16(const void*gsrc,unsigned lds_dst){unsigned keep;
  asm volatile("s_mov_b32 %0, m0\n\ts_mov_b32 m0, %2\n\ts_nop 0\n\tglobal_load_lds_dwordx4 %1, off\n\ts_mov_b32 m0, %0":"=&s"(keep):"v"(gsrc),"s"(lds_dst):"memory");}
__device__ __forceinline__ float max3f(float a,float b,float c){float r;asm("v_max3_f32 %0, %1, %2, %3":"=v"(r):"v"(a),"v"(b),"v"(c));return r;}
__device__ __forceinline__ float max2f(float a,float b){float r;asm("v_max_f32_e32 %0, %1, %2":"=v"(r):"v"(a),"v"(b));return r;}
__device__ __forceinline__ float fadd_s(float a,float b){float r;asm("v_add_f32_e32 %0, %1, %2":"=v"(r):"v"(a),"v"(b));return r;}
__device__ __forceinline__ float fsub_s(float a,float b){float r;asm("v_sub_f32_e32 %0, %1, %2":"=v"(r):"v"(a),"v"(b));return r;}
typedef float f32x2_t __attribute__((ext_vector_type(2))); typedef __bf16 bf16x2_t __attribute__((ext_vector_type(2)));
__device__ __forceinline__ unsigned cvtpk_s(float lo,float hi){f32x2_t v={lo,hi};bf16x2_t b=__builtin_convertvector(v,bf16x2_t);return __builtin_bit_cast(unsigned,b);}
#define WAIT_BAR(N) asm volatile("s_waitcnt vmcnt(" #N ") lgkmcnt(0)\n\ts_barrier":::"memory")

__device__ __forceinline__ void qkt(f32x16&p0,f32x16&p1,const char*Kslot,const bf16x8*qr,const f32x16&negm,int r32,int hi){
  const char*kb=Kslot+hi*1024+r32*16;
  #pragma unroll
  for(int d0=0;d0<4;++d0){
    const bf16x8 b0=*reinterpret_cast<const bf16x8*>(kb+d0*2048);
    const bf16x8 b1=*reinterpret_cast<const bf16x8*>(kb+d0*2048+512);
    if(d0==0){p0=__builtin_amdgcn_mfma_f32_32x32x16_bf16(b0,qr[0],negm,0,0,0);p1=__builtin_amdgcn_mfma_f32_32x32x16_bf16(b1,qr[0],negm,0,0,0);}
    else{p0=__builtin_amdgcn_mfma_f32_32x32x16_bf16(b0,qr[d0],p0,0,0,0);p1=__builtin_amdgcn_mfma_f32_32x32x16_bf16(b1,qr[d0],p1,0,0,0);}}
}
typedef __attribute__((address_space(3))) const char* lds_cptr;
typedef short v4i16_t __attribute__((ext_vector_type(4)));
__device__ __forceinline__ void kload8(bf16x8*kf,lds_cptr kp){
  kf[0]=*(const __attribute__((address_space(3))) bf16x8*)(kp);      kf[1]=*(const __attribute__((address_space(3))) bf16x8*)(kp+512);
  kf[2]=*(const __attribute__((address_space(3))) bf16x8*)(kp+2048); kf[3]=*(const __attribute__((address_space(3))) bf16x8*)(kp+2560);
  kf[4]=*(const __attribute__((address_space(3))) bf16x8*)(kp+4096); kf[5]=*(const __attribute__((address_space(3))) bf16x8*)(kp+4608);
  kf[6]=*(const __attribute__((address_space(3))) bf16x8*)(kp+6144); kf[7]=*(const __attribute__((address_space(3))) bf16x8*)(kp+6656);
}
__device__ __forceinline__ void kload2(bf16x8*kf,lds_cptr kp,int j){ kf[2*j]=*(const __attribute__((address_space(3))) bf16x8*)(kp+j*2048); kf[2*j+1]=*(const __attribute__((address_space(3))) bf16x8*)(kp+j*2048+512); }
__device__ __forceinline__ s16x4 vtr(lds_cptr p){ return __builtin_bit_cast(s16x4,__builtin_amdgcn_ds_read_tr16_b64_v4i16((__attribute__((address_space(3))) v4i16_t*)p)); }
__device__ __forceinline__ float rowmax(const f32x16&p0,const f32x16&p1){
  float a=max3f(p0[0],p0[1],p1[0]),b=max3f(p0[2],p0[3],p1[1]);a=max3f(a,p1[2],p1[3]);
  #pragma unroll
  for(int r=4;r<16;r+=4){a=max3f(a,p0[r],p0[r+1]);b=max3f(b,p0[r+2],p0[r+3]);a=max3f(a,p1[r],p1[r+1]);b=max3f(b,p1[r+2],p1[r+3]);}
  const float m=max2f(a,b);
  auto rr=__builtin_amdgcn_permlane32_swap(__float_as_uint(m),__float_as_uint(m),false,false);
  return max2f(__uint_as_float(rr[0]),__uint_as_float(rr[1]));
}
__device__ __forceinline__ void pv(f32x16*o,int vb,bf16x8 pa0,bf16x8 pa1,bf16x8 pa2,bf16x8 pa3){
  #pragma unroll
  for(int d0=0;d0<2;++d0){s16x4 lo[4],hi[4];
    #pragma unroll
    for(int ks=0;ks<4;++ks){
      asm volatile("ds_read_b64_tr_b16 %0,%1 offset:%c2":"=&v"(lo[ks]):"v"(vb),"i"(d0*4096+ks*1024):"memory");
      asm volatile("ds_read_b64_tr_b16 %0,%1 offset:%c2":"=&v"(hi[ks]):"v"(vb),"i"(d0*4096+ks*1024+512):"memory");}
    asm volatile("s_waitcnt lgkmcnt(0)":::"memory");SBAR();
    #define PK(k) (bf16x8){lo[k][0],lo[k][1],lo[k][2],lo[k][3],hi[k][0],hi[k][1],hi[k][2],hi[k][3]}
    o[d0]=__builtin_amdgcn_mfma_f32_32x32x16_bf16(pa0,PK(0),o[d0],0,0,0);
    o[d0]=__builtin_amdgcn_mfma_f32_32x32x16_bf16(pa1,PK(1),o[d0],0,0,0);
    o[d0]=__builtin_amdgcn_mfma_f32_32x32x16_bf16(pa2,PK(2),o[d0],0,0,0);
    o[d0]=__builtin_amdgcn_mfma_f32_32x32x16_bf16(pa3,PK(3),o[d0],0,0,0);
    #undef PK
  }
}

__device__ __forceinline__ void pv2(f32x16*o,int vb,bf16x8 pa0,bf16x8 pa1,bf16x8 pa2,bf16x8 pa3){
  s16x4 lo[8],hi[8];
  #pragma unroll
  for(int d0=0;d0<2;++d0){
    #pragma unroll
    for(int ks=0;ks<4;++ks){
      asm volatile("ds_read_b64_tr_b16 %0,%1 offset:%c2":"=&v"(lo[d0*4+ks]):"v"(vb),"i"(d0*4096+ks*1024):"memory");
      asm volatile("ds_read_b64_tr_b16 %0,%1 offset:%c2":"=&v"(hi[d0*4+ks]):"v"(vb),"i"(d0*4096+ks*1024+512):"memory");}}
  asm volatile("s_waitcnt lgkmcnt(0)":::"memory");SBAR();
  #define PK2(k) (bf16x8){lo[k][0],lo[k][1],lo[k][2],lo[k][3],hi[k][0],hi[k][1],hi[k][2],hi[k][3]}
  o[0]=__builtin_amdgcn_mfma_f32_32x32x16_bf16(pa0,PK2(0),o[0],0,0,0); o[1]=__builtin_amdgcn_mfma_f32_32x32x16_bf16(pa0,PK2(4),o[1],0,0,0);
  o[0]=__builtin_amdgcn_mfma_f32_32x32x16_bf16(pa1,PK2(1),o[0],0,0,0); o[1]=__builtin_amdgcn_mfma_f32_32x32x16_bf16(pa1,PK2(5),o[1],0,0,0);
  o[0]=__builtin_amdgcn_mfma_f32_32x32x16_bf16(pa2,PK2(2),o[0],0,0,0); o[1]=__builtin_amdgcn_mfma_f32_32x32x16_bf16(pa2,PK2(6),o[1],0,0,0);
  o[0]=__builtin_amdgcn_mfma_f32_32x32x16_bf16(pa3,PK2(3),o[0],0,0,0); o[1]=__builtin_amdgcn_mfma_f32_32x32x16_bf16(pa3,PK2(7),o[1],0,0,0);
  #undef PK2
}

#ifndef ATTN_STORE16
#define ATTN_STORE16(p,v) (*(u32x4*)(p)=(v))
#endif
template<int THRL,bool GUARD> __device__ __forceinline__ void attn_unit(int b,int cq,int cv,int co,int qb,const bf16*Q,const bf16*__restrict__ K,const bf16*__restrict__ V,bf16*O,char*shm){
  int tid=threadIdx.x; asm volatile("":"+v"(tid)); const int lane=tid&63,r32=lane&31,hi=lane>>5; const int wid=__builtin_amdgcn_readfirstlane(tid>>6);
  const long rowbase=(long)b*SEQ; const int q0=qb*QB;
  const bf16*Qw=Q+(rowbase+q0+wid*QBLK)*PQ+cq;
  const bf16*Kh=K+rowbase*PQ+cq,*Vh=V+rowbase*PV+cv;
  const unsigned lds0=(unsigned)(uintptr_t)shm;
  float*wsf=(float*)(shm+LDS_WS)+wid*64;
  const bf16*ksrc=Kh+(long)lane*PQ+wid*8;
  const bf16*vsrc=Vh+(long)(16*(wid&3)+(lane>>2))*PV+(wid>>2)*32+(lane&3)*8;
  const unsigned kdst=lds0+LDS_K+wid*1024, vdst=lds0+LDS_V+wid*1024;
  #define DMA_K(t,slot) glds16(ksrc+(long)(t)*KVBLK*PQ,(unsigned)__builtin_amdgcn_readfirstlane(kdst+(slot)))
  #define DMA_V(t,slot) do{ glds16(vsrc+(long)(t)*KVBLK*PV,(unsigned)__builtin_amdgcn_readfirstlane(vdst+2*(slot))); glds16(vsrc+64+(long)(t)*KVBLK*PV,(unsigned)__builtin_amdgcn_readfirstlane(vdst+2*(slot)+8192)); }while(0)
  const int vb0=(int)(lds0+LDS_V)+((lane>>4)&1)*32+(lane&3)*8+(4*hi+((lane&15)>>2))*64;
  const char*Kbase=shm+LDS_K; bf16x8 kf[8];
  const lds_cptr shm3=(lds_cptr)shm; const lds_cptr kp0=shm3+LDS_K+hi*1024+r32*16; const lds_cptr vp0=shm3+LDS_V+((lane>>4)&1)*32+(lane&3)*8+(4*hi+((lane&15)>>2))*64;
  const int NT=(q0+QB)/KVBLK;
  DMA_K(0,0);DMA_V(0,0);DMA_K(1,SLOTB);
  bf16x8 qr[4];
  #pragma unroll
  for(int d0=0;d0<4;++d0)qr[d0]=*reinterpret_cast<const bf16x8*>(&Qw[(long)r32*PQ+d0*16+hi*8]);
  float mhat=0.f,l_reg=0.f;f32x16 o[4];o[0]=f32x16{};o[1]=f32x16{};o[2]=f32x16{};o[3]=f32x16{};const f32x16 zero16=f32x16{};
  const int qrel=wid*QBLK+r32;
  #define CMASK(P0,P1,t) do{int jb_=(t)-(NT-4); if(jb_>=0)cmask(P0,P1,jb_,qrel,hi);}while(0)
  bool resc=false;
  #define START(P0,P1) do{ resc=false; \
    if(GUARD){ const float rm=rowmax(P0,P1); const float dl=rm; mhat=fadd_s(mhat,dl); \
      _Pragma("unroll") for(int r=0;r<16;++r){P0[r]=fsub_s(P0[r],dl);P1[r]=fsub_s(P1[r],dl);} } \
    _Pragma("unroll") for(int r=0;r<16;++r)P0[r]=__builtin_amdgcn_exp2f(P0[r]); }while(0)
  #define RESC() do{ if(GUARD&&resc){ asm volatile("s_waitcnt lgkmcnt(0)":::"memory"); \
      _Pragma("unroll") for(int d_=0;d_<4;++d_) _Pragma("unroll") for(int r=0;r<16;++r)o[d_][r]*=wsf[crow(r,hi)]; } }while(0)
  f32x16 pA0,pA1,pB0,pB1;
  int sl_prev=0,sl_cur=0,sl_next=SLOTB;
  #define ROT() do{sl_prev=sl_cur;sl_cur=sl_next;sl_next=(sl_next==(NSLOT-1)*SLOTB)?0:sl_next+SLOTB;}while(0)
  DMA_K(2,2*SLOTB);
  WAIT_BAR(4);
  qkt(pA0,pA1,Kbase,qr,zero16,r32,hi);asm volatile("s_nop 15\n\ts_nop 7":"+v"(pA0),"+v"(pA1));CMASK(pA0,pA1,0);
  START(pA0,pA1);
  _Pragma("unroll") for(int r=0;r<16;++r)pA1[r]=__builtin_amdgcn_exp2f(pA1[r]);
  WAIT_BAR(0);
  DMA_K(3,0);DMA_V(1,SLOTB);
  ROT();
  kload8(kf,kp0+sl_cur);
  WAIT_BAR(3);
  s16x4 vlo[8],vhi[8]; u32x4 pw0,pw1,pw2,pw3;
  #define PKW(P,B) cvtpk_s(P[B],P[B+1])
  #define PAF(k) __builtin_bit_cast(bf16x8,pw##k)
  #define VFR(i) (bf16x8){vlo[i][0],vlo[i][1],vlo[i][2],vlo[i][3],vhi[i][0],vhi[i][1],vhi[i][2],vhi[i][3]}
  #define PIN(x) asm volatile("":"+v"(x))
  #define MX3(a,b,c) __builtin_fmaxf(__builtin_fmaxf((a),(b)),(c))
  #define GAPA(MF,A0,A1,A2,A3,W0,W1,PW) do{ MF; sacc+=A0; sacc+=A1; sacc+=A2; sacc+=A3; PIN(sacc); W0; W1; PIN(PW); SBAR(); }while(0)
  #define EX(v) __builtin_amdgcn_exp2f(v)
  #define GAPB(MF,X,B) do{ MF; X[B]=EX(X[B]); X[B+1]=EX(X[B+1]); X[B+2]=EX(X[B+2]); X[B+3]=EX(X[B+3]); PIN(X); SBAR(); }while(0)
  #define VRD(i) do{ vlo[i]=vtr(vp_+(((i)>>2)*4096+((i)&3)*1024)); vhi[i]=vtr(vp_+(((i)>>2)*4096+((i)&3)*1024+512)); }while(0)
  #define VRD2(i) do{ vlo[i]=vtr(vp_+(8192+((i)>>2)*4096+((i)&3)*1024)); vhi[i]=vtr(vp_+(8192+((i)>>2)*4096+((i)&3)*1024+512)); }while(0)
  #define KRD(G,j) do{ if(G){ kload2(kf,kp0+sl_next,j); SBAR(); } }while(0)
  #define STEP(C0,C1,P0,P1,t,GK,GV,GL) do{ SBAR(); \
    const lds_cptr vp_=vp0+2*sl_prev; \
    VRD(0); SBAR(); float sacc=(P0[0]+P0[1]); \
    GAPA(C0=__builtin_amdgcn_mfma_f32_32x32x16_bf16(kf[0],qr[0],zero16,0,0,0), P0[2],P0[3],P0[4],P0[5],     pw0[0]=PKW(P0,0), pw0[1]=PKW(P0,2), pw0); \
    VRD(4); SBAR(); GAPA(C1=__builtin_amdgcn_mfma_f32_32x32x16_bf16(kf[1],qr[0],zero16,0,0,0), P0[6],P0[7],P0[8],P0[9],     pw0[2]=PKW(P0,4), pw0[3]=PKW(P0,6), pw0); \
    VRD(1); SBAR(); GAPA(C0=__builtin_amdgcn_mfma_f32_32x32x16_bf16(kf[2],qr[1],C0,0,0,0),   P0[10],P0[11],P0[12],P0[13], pw1[0]=PKW(P0,8), pw1[1]=PKW(P0,10), pw1); \
    VRD(5); SBAR(); GAPA(C1=__builtin_amdgcn_mfma_f32_32x32x16_bf16(kf[3],qr[1],C1,0,0,0),   P0[14],P0[15],P1[0],P1[1],   pw1[2]=PKW(P0,12),pw1[3]=PKW(P0,14), pw1); \
    VRD(2); SBAR(); GAPA(C0=__builtin_amdgcn_mfma_f32_32x32x16_bf16(kf[4],qr[2],C0,0,0,0),   P1[2],P1[3],P1[4],P1[5],     pw2[0]=PKW(P1,0), pw2[1]=PKW(P1,2), pw2); \
    VRD(6); SBAR(); GAPA(C1=__builtin_amdgcn_mfma_f32_32x32x16_bf16(kf[5],qr[2],C1,0,0,0),   P1[6],P1[7],P1[8],P1[9],     pw2[2]=PKW(P1,4), pw2[3]=PKW(P1,6), pw2); \
    VRD(3); SBAR(); GAPA(C0=__builtin_amdgcn_mfma_f32_32x32x16_bf16(kf[6],qr[3],C0,0,0,0),   P1[10],P1[11],P1[12],P1[13], pw3[0]=PKW(P1,8), pw3[1]=PKW(P1,10), pw3); \
    VRD(7); SBAR(); GAPA(C1=__builtin_amdgcn_mfma_f32_32x32x16_bf16(kf[7],qr[3],C1,0,0,0),   P1[14],P1[15],0.f,0.f,       pw3[2]=PKW(P1,12),pw3[3]=PKW(P1,14), pw3); \
    l_reg+=sacc; \
    if(GK){DMA_K((t)+3,sl_cur);} if(GV){DMA_V((t)+1,sl_next);} \
    if(GUARD){ _Pragma("unroll") for(int r=0;r<16;++r){C0[r]-=mhat;C1[r]-=mhat;} } \
    CMASK(C0,C1,t); \
    resc=false; \
    if(GUARD){ float a=MX3(C0[0],C0[1],C1[0]),b=MX3(C0[2],C0[3],C1[1]); a=MX3(a,C1[2],C1[3]); \
      _Pragma("unroll") for(int r=4;r<16;r+=4){a=MX3(a,C0[r],C0[r+1]);b=MX3(b,C0[r+2],C0[r+3]);a=MX3(a,C1[r],C1[r+1]);b=MX3(b,C1[r+2],C1[r+3]);} \
      float rm=__builtin_fmaxf(a,b); { auto rr=__builtin_amdgcn_permlane32_swap(__float_as_uint(rm),__float_as_uint(rm),false,false); rm=__builtin_fmaxf(__uint_as_float(rr[0]),__uint_as_float(rr[1])); } \
      resc=false; \
      if(__builtin_expect(__any(rm>(float)THRL),0)){ const float dl=__builtin_fmaxf(rm,0.f); mhat+=dl; \
        _Pragma("unroll") for(int r=0;r<16;++r){C0[r]-=dl;C1[r]-=dl;} \
        const float f=__builtin_amdgcn_exp2f(-dl); l_reg*=f; if(hi==0)wsf[r32]=f; resc=true; } } \
    SBAR(); \
    GAPB(o[0]=__builtin_amdgcn_mfma_f32_32x32x16_bf16(PAF(0),VFR(0),o[0],0,0,0), C0,0); \
    GAPB(o[1]=__builtin_amdgcn_mfma_f32_32x32x16_bf16(PAF(0),VFR(4),o[1],0,0,0), C0,4); \
    KRD(GL,0); GAPB(o[0]=__builtin_amdgcn_mfma_f32_32x32x16_bf16(PAF(1),VFR(1),o[0],0,0,0), C0,8); \
    KRD(GL,1); GAPB(o[1]=__builtin_amdgcn_mfma_f32_32x32x16_bf16(PAF(1),VFR(5),o[1],0,0,0), C0,12); \
    KRD(GL,2); GAPB(o[0]=__builtin_amdgcn_mfma_f32_32x32x16_bf16(PAF(2),VFR(2),o[0],0,0,0), C1,0); \
    KRD(GL,3); GAPB(o[1]=__builtin_amdgcn_mfma_f32_32x32x16_bf16(PAF(2),VFR(6),o[1],0,0,0), C1,4); \
    GAPB(o[0]=__builtin_amdgcn_mfma_f32_32x32x16_bf16(PAF(3),VFR(3),o[0],0,0,0), C1,8); \
    GAPB(o[1]=__builtin_amdgcn_mfma_f32_32x32x16_bf16(PAF(3),VFR(7),o[1],0,0,0), C1,12); \
    pv2(o+2,vb0+2*sl_prev+8192,PAF(0),PAF(1),PAF(2),PAF(3)); \
    }while(0)
  int t=1;
  #undef CMASK
  #define CMASK(P0,P1,t) do{}while(0)
  for(;t+5<NT;t+=2){
    STEP(pB0,pB1,pA0,pA1,t,true,true,true);     WAIT_BAR(3); RESC(); ROT();
    STEP(pA0,pA1,pB0,pB1,t+1,true,true,true);   WAIT_BAR(3); RESC(); ROT();
  }
  #undef CMASK
  #define CMASK(P0,P1,t) do{int jb_=(t)-(NT-4); if(jb_>=0)cmask(P0,P1,jb_,qrel,hi);}while(0)
  #define ENDW(tt) do{ if((tt)+3<NT){WAIT_BAR(3);} else if((tt)+2<NT){WAIT_BAR(2);} else {WAIT_BAR(0);} }while(0)
  for(;t+1<NT;t+=2){
    STEP(pB0,pB1,pA0,pA1,t,(t+3<NT),(t+1<NT),(t+1<NT));       ENDW(t);   RESC(); ROT();
    STEP(pA0,pA1,pB0,pB1,t+1,(t+4<NT),(t+2<NT),(t+2<NT));     ENDW(t+1); RESC(); ROT();
  }
  STEP(pB0,pB1,pA0,pA1,NT-1,false,false,false); RESC();
  { float sacc=pB0[0]+pB0[1]; _Pragma("unroll") for(int r=2;r<16;++r)sacc+=pB0[r]; _Pragma("unroll") for(int r=0;r<16;++r)sacc+=pB1[r]; l_reg+=sacc;
    pw0=(u32x4){PKW(pB0,0),PKW(pB0,2),PKW(pB0,4),PKW(pB0,6)};pw1=(u32x4){PKW(pB0,8),PKW(pB0,10),PKW(pB0,12),PKW(pB0,14)};pw2=(u32x4){PKW(pB1,0),PKW(pB1,2),PKW(pB1,4),PKW(pB1,6)};pw3=(u32x4){PKW(pB1,8),PKW(pB1,10),PKW(pB1,12),PKW(pB1,14)};
    SBAR(); pv(o,vb0+2*sl_cur,PAF(0),PAF(1),PAF(2),PAF(3)); pv(o+2,vb0+2*sl_cur+8192,PAF(0),PAF(1),PAF(2),PAF(3)); }
  #undef PKW
  #undef PAF
  #undef VFR
  #undef PIN
  #undef MX3
  #undef GAPA
  #undef GAPB
  #undef EX
  #undef VRD
  #undef VRD2
  #undef KRD
  #undef STEP
  #undef ENDW
  {auto rr=__builtin_amdgcn_permlane32_swap(__float_as_uint(l_reg),__float_as_uint(l_reg),false,false);l_reg=__uint_as_float(rr[0])+__uint_as_float(rr[1]);}
  if(hi==0)wsf[32+r32]=l_reg;asm volatile("s_waitcnt lgkmcnt(0)":::"memory");
  float rli[16];
  #pragma unroll
  for(int r=0;r<16;++r)rli[r]=__builtin_amdgcn_rcpf(wsf[32+crow(r,hi)]);
  bf16*Ow=O+(rowbase+q0+wid*QBLK)*PO+co;
  { bf16*stg=(bf16*)(shm+LDS_OST)+wid*2048;
    int lane_e=lane; asm volatile("":"+v"(lane_e));
    #pragma unroll
    for(int half=0;half<2;++half){
      #pragma unroll
      for(int r=0;r<16;++r){const int orow=crow(r,hi);
        #pragma unroll
        for(int d0=0;d0<2;++d0)stg[orow*64+d0*32+r32]=__float2bfloat16(o[2*half+d0][r]*rli[r]);}
      asm volatile("s_waitcnt lgkmcnt(0)":::"memory");
      #pragma unroll
      for(int i=0;i<4;++i){const int row=i*8+(lane_e>>3),ch=lane_e&7; const u32x4 v=*(const u32x4*)(stg+row*64+ch*8); ATTN_STORE16(Ow+(long)row*PO+half*64+ch*8,v);}
      asm volatile("s_waitcnt lgkmcnt(0)":::"memory"); } }
  asm volatile("s_waitcnt lgkmcnt(0)\n\ts_barrier":::"memory");
  #undef DMA_K
  #undef DMA_V
  #undef CMASK
  #undef START
  #undef RESC
  #undef ROT
}
constexpr int ATTN_LDS_BYTES=LDS_BYTES;
#undef SBAR
#undef WAIT_BAR
}
#define GAS __attribute__((address_space(1)))
#define LAS __attribute__((address_space(3)))
typedef unsigned short bf16;
typedef unsigned v4u __attribute__((ext_vector_type(4)));
typedef unsigned v2u __attribute__((ext_vector_type(2)));
typedef float f32x4 __attribute__((ext_vector_type(4)));
typedef float f32x2 __attribute__((ext_vector_type(2)));
typedef short bf16x8 __attribute__((ext_vector_type(8)));

constexpr int NWAVES = 8, NTHR = 512;
constexpr int M = 16384, SEQ = 8192, DM = 1024, DPROJ = 3588, NPROJ = 3840, DMIX = 1280, DFF = 2816, DEPTH = 2;
constexpr float EPS = 1e-6f;
constexpr float C2Q = 0.125f * 1.4426950408889634f;
constexpr int M2L = 128, M2NC = SEQ / M2L;
constexpr int S5L = 128, S5NC = SEQ / S5L;
constexpr int FFN_MT = 67;

constexpr size_t MiB = 1u << 20;
constexpr size_t WS_SSQ = 0;
constexpr size_t WS_DTRAW = 1 * MiB;
constexpr size_t WS_DTV = WS_DTRAW + 256 * 1024;
constexpr size_t WS_ROPE = WS_DTV + 256 * 1024;
constexpr size_t WS_S5LB = 2 * MiB;
constexpr size_t WS_S5BB = WS_S5LB + 16 * 1024;
constexpr size_t WS_M2CD = WS_S5BB + 128 * 1024;
constexpr size_t WS_S5ST = 3 * MiB;
constexpr size_t WS_W = 4 * MiB;
constexpr size_t WS_WIN = WS_W;
constexpr size_t WS_WOUT = WS_WIN + (size_t)NPROJ * DM * 2;
constexpr size_t WS_WGU = WS_WOUT + (size_t)DM * DMIX * 2;
constexpr size_t WS_WDN = WS_WGU + (size_t)2 * DFF * DM * 2;
constexpr size_t WS_WGLU = WS_WDN + (size_t)DM * DFF * 2;
static_assert(WS_WGLU + 256 * 256 * 2 <= 32 * MiB, "weights");
constexpr size_t WS_XB = 32 * MiB + 8192;
constexpr size_t WS_MIX = 65 * MiB;
constexpr size_t WS_M2ST = 202 * MiB;
constexpr size_t WS_QK = 114 * MiB;
constexpr size_t WS_V = 146 * MiB;
constexpr size_t WS_Z = 162 * MiB;
constexpr size_t WS_SC = 170 * MiB;
constexpr size_t WS_S5U = 105 * MiB;
constexpr size_t WS_OA = 170 * MiB;
constexpr size_t WS_XBC = 202 * MiB;
constexpr size_t WS_XACT = 226 * MiB;
constexpr size_t WS_A2 = 114 * MiB;
constexpr size_t WS_RSTD = 250 * MiB + 65536;
constexpr size_t WS_CTL = 250 * MiB, CTL_BYTES = 16384;
constexpr size_t WS_END = 251 * MiB;

constexpr int LDS_BYTES = 135168;
constexpr int LDS_BARST = 131072;

__device__ __forceinline__ unsigned f2bf(float f) { unsigned u = __builtin_bit_cast(unsigned, f); return (u + 0x7fffu + ((u >> 16) & 1u)) >> 16; }
__device__ __forceinline__ unsigned pk2(float lo, float hi) { return pg8::cvt_pk_bf16(lo, hi); }
__device__ __forceinline__ float bflo(unsigned w) { return __builtin_bit_cast(float, w << 16); }
__device__ __forceinline__ float bfhi(unsigned w) { return __builtin_bit_cast(float, w & 0xffff0000u); }
__device__ __forceinline__ float bf1(bf16 h) { return __builtin_bit_cast(float, (unsigned)h << 16); }
__device__ __forceinline__ void unpack8(v4u w, float* f) { f[0] = bflo(w.x); f[1] = bfhi(w.x); f[2] = bflo(w.y); f[3] = bfhi(w.y); f[4] = bflo(w.z); f[5] = bfhi(w.z); f[6] = bflo(w.w); f[7] = bfhi(w.w); }
__device__ __forceinline__ v4u pack8(const float* f) { v4u w; w.x = pk2(f[0], f[1]); w.y = pk2(f[2], f[3]); w.z = pk2(f[4], f[5]); w.w = pk2(f[6], f[7]); return w; }
__device__ __forceinline__ float siluf(float x) { return x * __builtin_amdgcn_rcpf(1.f + __expf(-x)); }
__device__ __forceinline__ float sigmf(float x) { return __builtin_amdgcn_rcpf(1.f + __expf(-x)); }
__device__ __forceinline__ float rstd_of(const float* ssq, int row) {
    const f32x4* p = (const f32x4*)(ssq + (size_t)row * 16); f32x4 a = p[0], b = p[1], c = p[2], d = p[3];
    const float s = ((a.x + a.y) + (a.z + a.w)) + ((b.x + b.y) + (b.z + b.w)) + ((c.x + c.y) + (c.z + c.w)) + ((d.x + d.y) + (d.z + d.w));
    return rsqrtf(s * (1.f / 1024.f) + EPS);
}

struct EpiInProj {
    static constexpr bool PERM = true, AFTER_DRAIN = false, OVL = false;
    bf16 *qk, *v, *sc, *s5u, *z, *xbc; float* dtraw; const float* rstd; const float* dtb;
    __device__ __forceinline__ void operator()(const pg8::f32x4 (&acc)[2][2][4][2], const pg8::Unit& u, int wr, int wc, int fr, int fq) const {
        const int pn = u.pn; const int row0 = u.pm * 256 + wr * 64 + fr, col0 = wc * 32 + 8 * fq; float rsv[2][4];
#pragma unroll
        for (int ai = 0; ai < 2; ++ai)
#pragma unroll
            for (int m = 0; m < 4; ++m) rsv[ai][m] = rstd[row0 + ai * 128 + m * 16];
        if (pn == 14) {
            if (wc == 0 && fq == 0) { const pg8::f32x4 db = *(const pg8::f32x4*)dtb;
#pragma unroll
                for (int ai = 0; ai < 2; ++ai)
#pragma unroll
                    for (int m = 0; m < 4; ++m) { const pg8::f32x4 x = acc[ai][0][m][0] * rsv[ai][m] + db; f32x4 o;
#pragma unroll
                        for (int j = 0; j < 4; ++j) o[j] = (x[j] > 20.f) ? x[j] : __logf(1.f + __expf(x[j]));
                        *(f32x4*)(dtraw + (size_t)(row0 + ai * 128 + m * 16) * 4) = o; } }
            return; }
        bf16* base; int ld;
        if (pn < 4) { base = qk + pn * 256; ld = 1024; } else if (pn < 6) { base = v + (pn - 4) * 256; ld = 512; } else if (pn < 9) { base = sc + (pn - 6) * 256; ld = 768; }
        else if (pn == 9) { base = s5u; ld = 256; } else if (pn == 10) { base = z; ld = 256; } else { base = xbc + (pn - 11) * 256; ld = 768; }
        bf16* p0 = base + (size_t)row0 * ld + col0;
#pragma unroll
        for (int ai = 0; ai < 2; ++ai)
#pragma unroll
            for (int m = 0; m < 4; ++m) { const float rs = rsv[ai][m]; bf16* pr = p0 + (size_t)(ai * 128 + m * 16) * ld;
#pragma unroll
                for (int bj = 0; bj < 2; ++bj) { const pg8::f32x4 v0 = acc[ai][bj][m][0] * rs, v1 = acc[ai][bj][m][1] * rs; v4u w;
                    w.x = pk2(v0[0], v0[1]); w.y = pk2(v0[2], v0[3]); w.z = pk2(v1[0], v1[1]); w.w = pk2(v1[2], v1[3]);
                    *(v4u*)(pr + bj * 128) = w; } }
    }
};
template <bool RES_F32, bool OUT_F32> struct EpiResid {
    static constexpr bool PERM = true, AFTER_DRAIN = false, OVL = false;
    const float* resid; float* out; bf16* xb; float* ssq;
    __device__ __forceinline__ void operator()(const pg8::f32x4 (&acc)[2][2][4][2], const pg8::Unit& u, int wr, int wc, int fr, int fq) const {
        const int col0 = u.pn * 256 + wc * 32 + 8 * fq; const size_t off0 = (size_t)(u.pm * 256 + wr * 64 + fr) * 1024 + col0; float sq[2][4];
#pragma unroll
        for (int ai = 0; ai < 2; ++ai) {
            v4u rb[4][2]; f32x4 rf[4][2][2];
#pragma unroll
            for (int m = 0; m < 4; ++m)
#pragma unroll
                for (int bj = 0; bj < 2; ++bj) { const size_t off = off0 + (size_t)(ai * 128 + m * 16) * 1024 + bj * 128;
                    if (RES_F32) { rf[m][bj][0] = *(const f32x4*)(resid + off); rf[m][bj][1] = *(const f32x4*)(resid + off + 4); } else rb[m][bj] = *(const v4u*)(xb + off); }
#pragma unroll
            for (int m = 0; m < 4; ++m) { float s = 0.f;
#pragma unroll
                for (int bj = 0; bj < 2; ++bj) { const size_t off = off0 + (size_t)(ai * 128 + m * 16) * 1024 + bj * 128; float r[8], o[8];
                    if (RES_F32) { const f32x4 r0 = rf[m][bj][0], r1 = rf[m][bj][1]; r[0] = r0.x; r[1] = r0.y; r[2] = r0.z; r[3] = r0.w; r[4] = r1.x; r[5] = r1.y; r[6] = r1.z; r[7] = r1.w; }
                    else unpack8(rb[m][bj], r);
#pragma unroll
                    for (int j = 0; j < 8; ++j) { o[j] = r[j] + acc[ai][bj][m][j >> 2][j & 3]; s += o[j] * o[j]; }
                    if (OUT_F32) { *(f32x4*)(out + off) = (f32x4){o[0], o[1], o[2], o[3]}; *(f32x4*)(out + off + 4) = (f32x4){o[4], o[5], o[6], o[7]}; }
                    *(v4u*)(xb + off) = pack8(o); }
                sq[ai][m] = s; } }
#pragma unroll
        for (int ai = 0; ai < 2; ++ai)
#pragma unroll
            for (int m = 0; m < 4; ++m) { float s = sq[ai][m]; s += __shfl_xor(s, 16); s += __shfl_xor(s, 32);
                ssq[(size_t)(u.pm * 256 + ai * 128 + wr * 64 + m * 16 + fr) * 16 + u.pn * 4 + wc] = s; }
    }
};
struct EpiFfn1 {
    static constexpr bool PERM = true, AFTER_DRAIN = false, OVL = true;
    bf16* a2; const float* rstd; const float* cw;
    __device__ __forceinline__ void operator()(const pg8::f32x4 (&acc)[2][2][4][2], const pg8::Unit& u, int wr, int wc, int fr, int fq) const {
        const int colh = u.pn * 128 + wc * 32 + 8 * fq; const int lane = threadIdx.x & 63;
        float w0[8], w1[8], w2[8];
#pragma unroll
        for (int q = 0; q < 2; ++q) { const f32x4 a0 = *(const f32x4*)(cw + colh + 4 * q), a1 = *(const f32x4*)(cw + DFF + colh + 4 * q), a2v = *(const f32x4*)(cw + 2 * DFF + colh + 4 * q);
#pragma unroll
            for (int j = 0; j < 4; ++j) { w0[4 * q + j] = a0[j]; w1[4 * q + j] = a1[j]; w2[4 * q + j] = a2v[j]; } }
        float rsv[2][4];
#pragma unroll
        for (int ai = 0; ai < 2; ++ai)
#pragma unroll
            for (int m = 0; m < 4; ++m) { const int tok = u.pm * 248 + (2 * ai + wr) * 62 - 2 + 16 * m + fr; rsv[ai][m] = rstd[tok < 0 ? 0 : (tok > M - 1 ? M - 1 : tok)]; }
#pragma unroll
        for (int ai = 0; ai < 2; ++ai) { const int tok0 = u.pm * 248 + (2 * ai + wr) * 62 - 2;
            float p1p[8], p2p[8];
#pragma unroll
            for (int j = 0; j < 8; ++j) { p1p[j] = 0.f; p2p[j] = 0.f; }
#pragma unroll
            for (int m = 0; m < 4; ++m) { const int tok = tok0 + 16 * m + fr; const float rs = rsv[ai][m];
                float G[8], U[8], r1[8], r2[8];
#pragma unroll
                for (int j = 0; j < 4; ++j) { G[j] = acc[ai][0][m][0][j] * rs; G[4 + j] = acc[ai][0][m][1][j] * rs; U[j] = acc[ai][1][m][0][j] * rs; U[4 + j] = acc[ai][1][m][1][j] * rs; }
#pragma unroll
                for (int j = 0; j < 8; ++j) { r1[j] = __builtin_bit_cast(float, __builtin_amdgcn_update_dpp(0, __builtin_bit_cast(int, G[j]), 0x121, 0xf, 0xf, false));
                    r2[j] = __builtin_bit_cast(float, __builtin_amdgcn_update_dpp(0, __builtin_bit_cast(int, G[j]), 0x122, 0xf, 0xf, false)); }
                const int tpos = tok & (SEQ - 1); float o[8];
#pragma unroll
                for (int j = 0; j < 8; ++j) { float a1 = fr >= 1 ? r1[j] : p1p[j], b2 = fr >= 2 ? r2[j] : p2p[j]; if (tpos < 1) a1 = 0.f; if (tpos < 2) b2 = 0.f;
                    const float g = w0[j] * b2 + w1[j] * a1 + w2[j] * G[j]; o[j] = siluf(g) * U[j]; p1p[j] = r1[j]; p2p[j] = r2[j]; }
                if ((16 * m + fr) >= 2 && tok < M) *(v4u*)(a2 + (size_t)tok * DFF + colh) = pack8(o); }
        }
    }
};
struct EpiGlu {
    static constexpr bool PERM = true, AFTER_DRAIN = false, OVL = false;
    bf16* mix; const float* bias;
    __device__ __forceinline__ void operator()(const pg8::f32x4 (&acc)[2][2][4][2], const pg8::Unit& u, int wr, int wc, int fr, int fq) const {
        const int row0 = u.pm * 256 + wr * 64 + fr, col0 = wc * 32 + 8 * fq; bf16* p0 = mix + (size_t)row0 * DMIX + 768 + col0;
#pragma unroll
        for (int ai = 0; ai < 2; ++ai)
#pragma unroll
            for (int bj = 0; bj < 2; ++bj) { v4u gv[4]; const f32x4 b0 = *(const f32x4*)(bias + bj * 128 + col0), b1 = *(const f32x4*)(bias + bj * 128 + col0 + 4);
#pragma unroll
                for (int m = 0; m < 4; ++m) gv[m] = *(const v4u*)(p0 + (size_t)(ai * 128 + m * 16) * DMIX + bj * 128);
#pragma unroll
                for (int m = 0; m < 4; ++m) { float gg[8], o[8]; unpack8(gv[m], gg);
#pragma unroll
                    for (int j = 0; j < 4; ++j) { o[j] = gg[j] * sigmf(acc[ai][bj][m][0][j] + b0[j]); o[4 + j] = gg[4 + j] * sigmf(acc[ai][bj][m][1][j] + b1[j]); }
                    *(v4u*)(p0 + (size_t)(ai * 128 + m * 16) * DMIX + bj * 128) = pack8(o); } }
    }
};
struct Args { const float* in[29]; float* out; unsigned char* ws; float ropeinv[8]; int ph_lo, ph_hi; };
typedef const __attribute__((address_space(4))) Args* CArgs;
enum { I_X = 0, I_LN1G, I_WIN, I_QKG, I_DALAM, I_SUBG, I_SCW, I_S5LRE, I_S5LIM, I_S5LDT, I_S5BRE, I_S5BIM, I_S5CRE, I_S5CIM, I_S5D, I_S5WGLU, I_S5BGLU,
       I_M2CW, I_M2CB, I_M2DTB, I_M2ALOG, I_M2D, I_M2NG, I_WOUT, I_LN2G, I_WG, I_WU, I_FCW, I_WD };
#define LDS_WAIT() asm volatile("s_waitcnt lgkmcnt(0)" ::: "memory")

__device__ __forceinline__ float wave_sum(float v) {
#pragma unroll
    for (int o = 1; o < 64; o <<= 1) v += __shfl_xor(v, o);
    return v;
}
__device__ __forceinline__ void sincos_f(float a, float& s, float& c) {
    const float n = __builtin_rintf(a * 0.6366197723675814f);
    float r = __builtin_fmaf(-n, 1.5703125f, a); r = __builtin_fmaf(-n, 4.837512969970703125e-4f, r); r = __builtin_fmaf(-n, 7.54978995489188216e-8f, r);
    const int q = (int)n & 3; const float r2 = r * r;
    const float sp = r + r * r2 * (-1.6666654611e-1f + r2 * (8.3321608736e-3f + r2 * (-1.9515295891e-4f)));
    const float cp = 1.0f - 0.5f * r2 + r2 * r2 * (4.166664568298827e-2f + r2 * (-1.388731625493765e-3f + r2 * 2.443315711809948e-5f));
    s = (q == 0) ? sp : (q == 1) ? cp : (q == 2) ? -sp : -cp;
    c = (q == 0) ? cp : (q == 1) ? -sp : (q == 2) ? -cp : sp;
}

__device__ __forceinline__ void tr_item(const float* W, int K, int N, int Npad, bf16* WT, const float* scale, int mode, LAS float* scr, int item, int lane) {
    const int nblk = Npad / 32, kb = item / nblk, nb = item % nblk, k0 = 64 * kb, n0 = 32 * nb;
    const int n4 = n0 + (lane & 7) * 4;
#pragma unroll
    for (int i = 0; i < 8; ++i) { const int kk = 8 * i + (lane >> 3); f32x4 v = (n4 < N) ? __builtin_nontemporal_load((const f32x4*)(W + (size_t)(k0 + kk) * N + n4)) : (f32x4){0.f, 0.f, 0.f, 0.f}; if (scale) v = v * scale[k0 + kk];
        LAS float* d = scr + kk * 33 + (lane & 7) * 4; d[0] = v.x; d[1] = v.y; d[2] = v.z; d[3] = v.w; }
    LDS_WAIT();
    const int c = lane & 7;
#pragma unroll
    for (int j = 0; j < 4; ++j) { const int nl = (lane >> 3) + 8 * j; const LAS float* s = scr + (8 * c) * 33 + nl;
        v4u o; o.x = pk2(s[0 * 33], s[1 * 33]); o.y = pk2(s[2 * 33], s[3 * 33]); o.z = pk2(s[4 * 33], s[5 * 33]); o.w = pk2(s[6 * 33], s[7 * 33]);
        const int nn = n0 + nl; const int row = (mode == 0) ? nn : (256 * (nn >> 7) + (nn & 127) + (mode == 2 ? 128 : 0));
        *(v4u*)(WT + (size_t)row * K + k0 + 8 * c) = o; }
    LDS_WAIT();
}

__device__ __forceinline__ void rstd_reduce(CArgs a, int gtid, int NT) {
    const float* ssq = (const float*)(a->ws + WS_SSQ); float* r = (float*)(a->ws + WS_RSTD);
    for (int row = gtid; row < M; row += NT) r[row] = rstd_of(ssq, row);
}
template <int REP> __device__ __forceinline__ void p0_convert(CArgs a, int l, LAS unsigned char* lds, int gw, int NGW, int gtid, int NT, int wave, int lane) {
    unsigned char* ws = a->ws;
    LAS float* scr = (LAS float*)(lds + wave * 8704);
    constexpr int I_IN = (DM / 64) * (NPROJ / 32), I_OUT = (DMIX / 64) * (DM / 32), I_G = (DM / 64) * (DFF / 32), I_D = (DFF / 64) * (DM / 32), I_GLU = (256 / 64) * (256 / 32);
    constexpr int NIT = I_IN + I_OUT + 2 * I_G + I_D + I_GLU;
    for (int it = gw; it < NIT; it += NGW) { int r = it;
        if (r < I_IN) { tr_item(a->in[I_WIN] + (size_t)l * DM * DPROJ, DM, DPROJ, NPROJ, (bf16*)(ws + WS_WIN), a->in[I_LN1G] + l * DM, 0, scr, r, lane); continue; } r -= I_IN;
        if (r < I_OUT) { tr_item(a->in[I_WOUT] + (size_t)l * DMIX * DM, DMIX, DM, DM, (bf16*)(ws + WS_WOUT), nullptr, 0, scr, r, lane); continue; } r -= I_OUT;
        if (r < I_G) { tr_item(a->in[I_WG] + (size_t)l * DM * DFF, DM, DFF, DFF, (bf16*)(ws + WS_WGU), a->in[I_LN2G] + l * DM, 1, scr, r, lane); continue; } r -= I_G;
        if (r < I_G) { tr_item(a->in[I_WU] + (size_t)l * DM * DFF, DM, DFF, DFF, (bf16*)(ws + WS_WGU), a->in[I_LN2G] + l * DM, 2, scr, r, lane); continue; } r -= I_G;
        if (r < I_D) { tr_item(a->in[I_WD] + (size_t)l * DFF * DM, DFF, DM, DM, (bf16*)(ws + WS_WDN), nullptr, 0, scr, r, lane); continue; } r -= I_D;
        tr_item(a->in[I_S5WGLU] + (size_t)l * 65536, 256, 256, 256, (bf16*)(ws + WS_WGLU), nullptr, 0, scr, r, lane);
    }
    if constexpr (REP == 1) return;
    for (int idx = gtid; idx < 1024; idx += NT) { const int g = idx >> 6;
        const float lr = a->in[I_S5LRE][l * 1024 + idx], li = a->in[I_S5LIM][l * 1024 + idx], dt = __expf(a->in[I_S5LDT][l * 16 + g]);
        float s, c; sincos_f(li * dt, s, c); const float mg = __expf(lr * dt); const float br = mg * c, bi = mg * s;
        float sL, cL; sincos_f(li * dt * (float)S5L, sL, cL); const float mL = __expf(lr * dt * (float)S5L);
        ((f32x4*)(ws + WS_S5LB))[idx] = (f32x4){br, bi, mL * cL, mL * sL};
        const float d2 = lr * lr + li * li, cr = ((br - 1.0f) * lr + bi * li) / d2, ci = (bi * lr - (br - 1.0f) * li) / d2;
        const f32x4* brp = (const f32x4*)(a->in[I_S5BRE] + ((size_t)l * 1024 + idx) * 16); const f32x4* bip = (const f32x4*)(a->in[I_S5BIM] + ((size_t)l * 1024 + idx) * 16);
        float xr[16], xi[16];
#pragma unroll
        for (int q = 0; q < 4; ++q) { const f32x4 vr = brp[q], vi = bip[q]; xr[4 * q] = vr.x; xr[4 * q + 1] = vr.y; xr[4 * q + 2] = vr.z; xr[4 * q + 3] = vr.w; xi[4 * q] = vi.x; xi[4 * q + 1] = vi.y; xi[4 * q + 2] = vi.z; xi[4 * q + 3] = vi.w; }
        { const int p = idx & 63, ct = p >> 3; v2u* bf = (v2u*)(ws + WS_S5BB) + ((size_t)(g * 8 + ct) * 64);
#pragma unroll
          for (int fq = 0; fq < 4; ++fq) { float br4[4], bi4[4];
#pragma unroll
              for (int jj = 0; jj < 4; ++jj) { const int hh = 4 * fq + jj; br4[jj] = cr * xr[hh] - ci * xi[hh]; bi4[jj] = cr * xi[hh] + ci * xr[hh]; }
              v2u wr_, wi_; wr_.x = pk2(br4[0], br4[1]); wr_.y = pk2(br4[2], br4[3]); wi_.x = pk2(bi4[0], bi4[1]); wi_.y = pk2(bi4[2], bi4[3]);
              bf[fq * 16 + 2 * (p & 7)] = wr_; bf[fq * 16 + 2 * (p & 7) + 1] = wi_; } }
    }
    if (l != 0) rstd_reduce(a, gtid, NT);
    if (l == 0) {
        const float* x = a->in[I_X]; bf16* XB = (bf16*)(ws + WS_XB); float* rstdp = (float*)(ws + WS_RSTD);
        for (int m0 = gw * 2; m0 < M; m0 += NGW * 2) { f32x4 v[2][4];
#pragma unroll
            for (int rr = 0; rr < 2; ++rr)
#pragma unroll
                for (int j = 0; j < 4; ++j) v[rr][j] = ((const f32x4*)(x + (size_t)(m0 + rr) * DM) + lane)[64 * j];
#pragma unroll
            for (int rr = 0; rr < 2; ++rr) { const int m = m0 + rr; v2u* o = (v2u*)(XB + (size_t)m * DM) + lane; float s = 0.f;
#pragma unroll
                for (int j = 0; j < 4; ++j) { const f32x4 t = v[rr][j]; s += (t.x * t.x + t.y * t.y) + (t.z * t.z + t.w * t.w); v2u w; w.x = pk2(t.x, t.y); w.y = pk2(t.z, t.w); o[64 * j] = w; }
                s = wave_sum(s); if (lane == 0) rstdp[m] = rsqrtf(s * (1.f / 1024.f) + EPS); } }
        float* rope = (float*)(ws + WS_ROPE);
        for (int idx = gtid; idx < SEQ * 8; idx += NT) { const int pos = idx >> 3, i = idx & 7; const float inv = (i == 0) ? a->ropeinv[0] : (i == 1) ? a->ropeinv[1] : (i == 2) ? a->ropeinv[2] : (i == 3) ? a->ropeinv[3] : (i == 4) ? a->ropeinv[4] : (i == 5) ? a->ropeinv[5] : (i == 6) ? a->ropeinv[6] : a->ropeinv[7]; const float ang = (float)pos * inv; float s, c; sincos_f(ang, s, c);
            rope[pos * 16 + i] = c; rope[pos * 16 + 8 + i] = s; }
    }
}

template <int REP> __device__ __forceinline__ void p2_prep(CArgs a, int l, int gw, int NGW, int gtid, int NT, int lane) {
    unsigned char* ws = a->ws;
    if constexpr (REP == 0) { bf16* QK = (bf16*)(ws + WS_QK); const float* rope = (const float*)(ws + WS_ROPE); const int isk = lane >> 5, quarter = lane & 3;
      const float* gq = a->in[I_QKG] + l * 128 + isk * 64 + quarter * 16; float gg[16];
#pragma unroll
      for (int j = 0; j < 16; ++j) gg[j] = gq[j] * (isk ? 1.f : C2Q);
      for (int tk = gw * 4; tk < M; tk += NGW * 4) { v4u rw[4][2]; f32x4 cs4[4][4];
#pragma unroll
          for (int rr = 0; rr < 4; ++rr) { const v4u* row = (const v4u*)(QK + (size_t)(tk + rr) * 1024 + lane * 16); rw[rr][0] = row[0]; rw[rr][1] = row[1];
              const f32x4* cs = (const f32x4*)(rope + ((tk + rr) & (SEQ - 1)) * 16);
#pragma unroll
              for (int q = 0; q < 4; ++q) cs4[rr][q] = cs[q]; }
#pragma unroll
          for (int rr = 0; rr < 4; ++rr) { v4u* row = (v4u*)(QK + (size_t)(tk + rr) * 1024 + lane * 16); float f[16]; unpack8(rw[rr][0], f); unpack8(rw[rr][1], f + 8); float ss = 0.f;
#pragma unroll
              for (int j = 0; j < 16; ++j) ss += f[j] * f[j];
              ss += __shfl_xor(ss, 1); ss += __shfl_xor(ss, 2); const float rs = rsqrtf(ss * (1.f / 64.f) + EPS);
#pragma unroll
              for (int j = 0; j < 16; ++j) f[j] = f[j] * rs * gg[j];
#pragma unroll
              for (int i = 0; i < 8; ++i) { const float c = (quarter == 0) ? cs4[rr][i >> 2][i & 3] : 1.f, s = (quarter == 0) ? cs4[rr][2 + (i >> 2)][i & 3] : 0.f, x1 = f[i], x2 = f[8 + i]; f[i] = x1 * c - x2 * s; f[8 + i] = x1 * s + x2 * c; }
              row[0] = pack8(f); row[1] = pack8(f + 8); } } }
    { const bf16* SC = (const bf16*)(ws + WS_SC); bf16* MIX = (bf16*)(ws + WS_MIX); const float* cw = a->in[I_SCW] + l * 768;
      for (int it = gtid; it < 32 * (M / 4); it += NT) { const int ch = (it & 31) * 8, t0 = (it >> 5) * 4; float w0[8], w1[8], w2[8], p1[8], p2[8];
#pragma unroll
          for (int j = 0; j < 8; ++j) { w0[j] = cw[ch + j]; w1[j] = cw[256 + ch + j]; w2[j] = cw[512 + ch + j]; p1[j] = 0.f; p2[j] = 0.f; }
          const bool first = (t0 & (SEQ - 1)) == 0; const bf16* r0 = SC + (size_t)t0 * 768 + ch;
          v4u pc[2], ph[2], vb[4], vc[4], vh[4];
#pragma unroll
          for (int u = 0; u < 2; ++u) { pc[u] = first ? (v4u){0u, 0u, 0u, 0u} : *(const v4u*)(r0 + (u - 2) * 768 + 256); ph[u] = first ? (v4u){0u, 0u, 0u, 0u} : *(const v4u*)(r0 + (u - 2) * 768 + 512); }
#pragma unroll
          for (int u = 0; u < 4; ++u) { vb[u] = *(const v4u*)(r0 + u * 768); vc[u] = *(const v4u*)(r0 + u * 768 + 256); vh[u] = *(const v4u*)(r0 + u * 768 + 512); }
          { float c8[8], h8[8]; unpack8(pc[0], c8); unpack8(ph[0], h8);
#pragma unroll
            for (int j = 0; j < 8; ++j) p2[j] = c8[j] * h8[j];
            unpack8(pc[1], c8); unpack8(ph[1], h8);
#pragma unroll
            for (int j = 0; j < 8; ++j) p1[j] = c8[j] * h8[j]; }
#pragma unroll
          for (int u = 0; u < 4; ++u) { float b8[8], c8[8], h8[8], o[8]; unpack8(vb[u], b8); unpack8(vc[u], c8); unpack8(vh[u], h8);
#pragma unroll
              for (int j = 0; j < 8; ++j) { const float p0 = c8[j] * h8[j]; o[j] = b8[j] * (w0[j] * p2[j] + w1[j] * p1[j] + w2[j] * p0); p2[j] = p1[j]; p1[j] = p0; }
              *(v4u*)(MIX + (size_t)(t0 + u) * DMIX + 512 + ch) = pack8(o); } } }
    { const bf16* XBC = (const bf16*)(ws + WS_XBC); bf16* XA = (bf16*)(ws + WS_XACT); const float* cw = a->in[I_M2CW] + l * 4 * 768; const float* cb = a->in[I_M2CB] + l * 768;
      for (int it = gtid; it < 32 * (M / 4); it += NT) { const int t0 = (it >> 5) * 4; const bool first = (t0 & (SEQ - 1)) == 0;
#pragma unroll
          for (int g3 = 0; g3 < 3; ++g3) { const int ch = ((it & 31) + 32 * g3) * 8; float w0[8], w1[8], w2[8], w3[8], bb[8], x1[8], x2[8], x3[8];
#pragma unroll
              for (int j = 0; j < 8; ++j) { w0[j] = cw[ch + j]; w1[j] = cw[768 + ch + j]; w2[j] = cw[1536 + ch + j]; w3[j] = cw[2304 + ch + j]; bb[j] = cb[ch + j]; x1[j] = 0.f; x2[j] = 0.f; x3[j] = 0.f; }
              v4u xv[7];
#pragma unroll
              for (int u = 0; u < 7; ++u) xv[u] = (first && u < 3) ? (v4u){0u, 0u, 0u, 0u} : *(const v4u*)(XBC + (size_t)(t0 - 3 + u) * 768 + ch);
              unpack8(xv[0], x3); unpack8(xv[1], x2); unpack8(xv[2], x1);
#pragma unroll
              for (int u = 0; u < 4; ++u) { float x0[8], o[8]; unpack8(xv[3 + u], x0);
#pragma unroll
                  for (int j = 0; j < 8; ++j) { o[j] = siluf(bb[j] + w0[j] * x3[j] + w1[j] * x2[j] + w2[j] * x1[j] + w3[j] * x0[j]); x3[j] = x2[j]; x2[j] = x1[j]; x1[j] = x0[j]; }
                  *(v4u*)(XA + (size_t)(t0 + u) * 768 + ch) = pack8(o); } } } }
}

typedef short s16x4v __attribute__((ext_vector_type(4)));
template <bool OUT> __device__ __forceinline__ void s5_pass(CArgs a, int l, LAS unsigned char* lds, int gw, int NGW, int wave, int lane) {
    unsigned char* ws = a->ws; const bf16* S5U = (const bf16*)(ws + WS_S5U); bf16* MIX = (bf16*)(ws + WS_MIX); f32x2* ST = (f32x2*)(ws + WS_S5ST);
    LAS bf16* Ub = (LAS bf16*)(lds + wave * 16384); LAS float* BUt = (LAS float*)(lds + wave * 16384 + 4096); LAS unsigned* Xt = (LAS unsigned*)(lds + wave * 16384 + 12288); LAS bf16* Yt = (LAS bf16*)(lds + wave * 16384 + 4096);
    const int fr = lane & 15, fq = lane >> 4;
    for (int unit = gw; unit < 2 * 16 * S5NC; unit += NGW) { const int c = unit % S5NC, g = (unit / S5NC) % 16, b = unit / (S5NC * 16); const int tok0 = b * SEQ + c * S5L;
#pragma unroll
        for (int r = 0; r < 2; ++r) { const int t = lane + 64 * r; const v4u* src = (const v4u*)(S5U + (size_t)(tok0 + t) * 256 + g * 16); const v4u u0 = src[0], u1 = src[1];
            *(LAS v4u*)(Ub + t * 16) = u0; *(LAS v4u*)(Ub + t * 16 + 8) = u1; }
        const f32x4 lb = ((const f32x4*)(ws + WS_S5LB))[g * 64 + lane]; s16x4v Bf[8];
#pragma unroll
        for (int ct = 0; ct < 8; ++ct) Bf[ct] = ((const s16x4v*)(ws + WS_S5BB))[(size_t)(g * 8 + ct) * 64 + lane];
        const f32x2 la = {lb.x, lb.x}, lbm = {-lb.y, lb.y};
        float xr = 0.f, xi = 0.f; bf16x8 Cf[4]; float dsk = 0.f;
        if (OUT) {
            const f32x2* stp = ST + ((size_t)(b * 16 + g) * S5NC) * 64 + lane;
            { const f32x2 s = stp[c * 64]; xr = s.x; xi = s.y; }
            const float* cre = a->in[I_S5CRE] + ((size_t)(l * 16 + g) * 16 + fr) * 64; const float* cim = a->in[I_S5CIM] + ((size_t)(l * 16 + g) * 16 + fr) * 64;
#pragma unroll
            for (int kk = 0; kk < 4; ++kk)
#pragma unroll
                for (int j = 0; j < 8; ++j) { const int k = 32 * kk + 8 * fq + j, p = k >> 1; const float v = (k & 1) ? -cim[p] : cre[p]; Cf[kk][j] = (short)f2bf(v); }
            dsk = a->in[I_S5D][l * 256 + g * 16 + fr];
        }
        LDS_WAIT();
        for (int t0 = 0; t0 < S5L; t0 += 16) {
            { const s16x4v av = *(const LAS s16x4v*)(Ub + (t0 + fr) * 16 + 4 * fq);
#pragma unroll
              for (int ct = 0; ct < 8; ++ct) { pg8::f32x4 acc = {0.f, 0.f, 0.f, 0.f}; acc = __builtin_amdgcn_mfma_f32_16x16x16bf16_1k(av, Bf[ct], acc, 0, 0, 0);
#pragma unroll
                  for (int i = 0; i < 4; ++i) BUt[(4 * fq + i) * 128 + 16 * ct + fr] = acc[i]; } }
            LDS_WAIT();
#pragma unroll 4
            for (int tt = 0; tt < 16; ++tt) { const f32x2 bu = *(const LAS f32x2*)(BUt + tt * 128 + 2 * lane);
                { const f32x2 xs = {xi, xr}; f32x2 xn = __builtin_elementwise_fma(la, (f32x2){xr, xi}, bu); xn = __builtin_elementwise_fma(lbm, xs, xn); xr = xn.x; xi = xn.y; }
                if (OUT) Xt[tt * 64 + lane] = pk2(xr, xi); }
            if (OUT) { LDS_WAIT(); pg8::f32x4 acc = {0.f, 0.f, 0.f, 0.f};
#pragma unroll
                for (int kk = 0; kk < 4; ++kk) { const bf16x8 av = *(const LAS bf16x8*)((const LAS unsigned char*)Xt + fr * 256 + (32 * kk + 8 * fq) * 2); acc = __builtin_amdgcn_mfma_f32_16x16x32_bf16(av, Cf[kk], acc, 0, 0, 0); }
#pragma unroll
                for (int i = 0; i < 4; ++i) { const int t = t0 + 4 * fq + i; const float y = acc[i] + dsk * bf1(Ub[t * 16 + fr]); const float zz = 0.7978845608028654f * (y + 0.044715f * y * y * y);
                    const float gl = y * __builtin_amdgcn_rcpf(1.f + __expf(-2.f * zz)); Yt[(4 * fq + i) * 16 + fr] = (bf16)f2bf(gl); }
                LDS_WAIT();
                if (lane < 32) { const v4u v = *(const LAS v4u*)(Yt + (lane >> 1) * 16 + (lane & 1) * 8); *(v4u*)(MIX + (size_t)(tok0 + t0 + (lane >> 1)) * DMIX + 768 + g * 16 + (lane & 1) * 8) = v; }
                LDS_WAIT(); }
            else LDS_WAIT();
        }
        if (!OUT) ST[((size_t)(b * 16 + g) * S5NC + c) * 64 + lane] = (f32x2){xr, xi};
        LDS_WAIT();
    }
}

constexpr int M2P = 136;
template <bool OUT> __device__ __forceinline__ void m2_pass(CArgs a, int l, LAS unsigned char* lds, int tid) {
    unsigned char* ws = a->ws; const bf16* XA = (const bf16*)(ws + WS_XACT); const float* dtv = (const float*)(ws + WS_DTV); float* ST = (float*)(ws + WS_M2ST); float* CD = (float*)(ws + WS_M2CD); bf16* MIX = (bf16*)(ws + WS_MIX);
    const int lane = tid & 63, wave = __builtin_amdgcn_readfirstlane(tid >> 6), fr = lane & 15, fq = lane >> 4;
    LAS bf16* R0 = (LAS bf16*)lds;
    LAS bf16* R1 = (LAS bf16*)(lds + 34816);
    LAS bf16* XT = (LAS bf16*)(lds + 69632);
    LAS bf16* Hs = (LAS bf16*)(lds + 87040);
    LAS float* csl = (LAS float*)(lds + 104448); LAS float* dtl = csl + 128;
    for (int unit = blockIdx.x; unit < 2 * 4 * M2NC; unit += gridDim.x) { const int c = unit % M2NC, h = (unit / M2NC) & 3, b = unit / (M2NC * 4), grp = h >> 1; const int tok0 = b * SEQ + c * M2L;
        const float A = -__expf(a->in[I_M2ALOG][l * 4 + h]), Dh = a->in[I_M2D][l * 4 + h];
        float* stu = ST + (size_t)unit * 8192;
        const bf16* prow = XA + (size_t)(tok0 + (tid >> 2)) * 768; const int pq = tid & 3;
        const v4u px0 = *(const v4u*)(prow + h * 64 + 16 * pq), px1 = *(const v4u*)(prow + h * 64 + 16 * pq + 8); v4u pb[4], pc[4];
#pragma unroll
        for (int u = 0; u < 4; ++u) { pb[u] = ((const v4u*)(prow + 256 + grp * 128 + 32 * pq))[u]; if (OUT) pc[u] = ((const v4u*)(prow + 512 + grp * 128 + 32 * pq))[u]; }
        __syncthreads();
        if (wave == 0) { const float d0 = dtv[(tok0 + 2 * lane) * 4 + h], d1 = dtv[(tok0 + 2 * lane + 1) * 4 + h]; const float v0 = A * d0, v1 = v0 + A * d1; float p = v1;
#pragma unroll
            for (int o = 1; o < 64; o <<= 1) { const float t = __shfl_up(p, o); if (lane >= o) p += t; }
            const float ex = p - v1; csl[2 * lane] = ex + v0; csl[2 * lane + 1] = ex + v1; dtl[2 * lane] = d0; dtl[2 * lane + 1] = d1; }
        __syncthreads();
        { const int t = tid >> 2, q = tid & 3; const float dtt = dtl[t];
          float xf[16]; unpack8(px0, xf); unpack8(px1, xf + 8);
          const float sc = OUT ? dtt : dtt * __expf(csl[127] - csl[t]);
          LAS bf16* xdst = OUT ? XT : R1;
#pragma unroll
          for (int j = 0; j < 16; ++j) xdst[(16 * q + j) * M2P + t] = (bf16)f2bf(xf[j] * sc);
          const v4u* bsrc = pb;
          if (OUT) { const v4u* csrc = pc;
#pragma unroll
              for (int u = 0; u < 4; ++u) { *(LAS v4u*)(R1 + t * M2P + 32 * q + 8 * u) = bsrc[u]; *(LAS v4u*)(R0 + t * M2P + 32 * q + 8 * u) = csrc[u]; } }
          else {
#pragma unroll
              for (int u = 0; u < 4; ++u) { const v4u w = bsrc[u]; const unsigned ww[4] = {w.x, w.y, w.z, w.w};
#pragma unroll
                  for (int j = 0; j < 4; ++j) { R0[(32 * q + 8 * u + 2 * j) * M2P + t] = (bf16)(ww[j] & 0xffffu); R0[(32 * q + 8 * u + 2 * j + 1) * M2P + t] = (bf16)(ww[j] >> 16); } } }
        }
        if (OUT) { const int p = tid >> 3, n0 = (tid & 7) * 16; const f32x4* src = (const f32x4*)(stu + p * 128 + n0); float hv[16];
#pragma unroll
            for (int u = 0; u < 4; ++u) { const f32x4 v = src[u]; hv[4 * u] = v.x; hv[4 * u + 1] = v.y; hv[4 * u + 2] = v.z; hv[4 * u + 3] = v.w; }
            *(LAS v4u*)(Hs + p * M2P + n0) = pack8(hv); *(LAS v4u*)(Hs + p * M2P + n0 + 8) = pack8(hv + 8); }
        __syncthreads();
        if (!OUT) { const int pt = wave >> 1, nt0 = (wave & 1) * 4; bf16x8 af[4];
#pragma unroll
            for (int kk = 0; kk < 4; ++kk) af[kk] = *(const LAS bf16x8*)(R1 + (16 * pt + fr) * M2P + 32 * kk + 8 * fq);
#pragma unroll
            for (int nt = 0; nt < 4; ++nt) { pg8::f32x4 acc = {0.f, 0.f, 0.f, 0.f};
#pragma unroll
                for (int kk = 0; kk < 4; ++kk) { const bf16x8 bfv = *(const LAS bf16x8*)(R0 + (16 * (nt0 + nt) + fr) * M2P + 32 * kk + 8 * fq); acc = __builtin_amdgcn_mfma_f32_16x16x32_bf16(af[kk], bfv, acc, 0, 0, 0); }
#pragma unroll
                for (int i = 0; i < 4; ++i) stu[(16 * pt + 4 * fq + i) * 128 + 16 * (nt0 + nt) + fr] = acc[i]; }
            if (tid == 0) CD[unit] = __expf(csl[127]);
        } else {
            bf16x8 aC[4];
#pragma unroll
            for (int kk = 0; kk < 4; ++kk) aC[kk] = *(const LAS bf16x8*)(R0 + (16 * wave + fr) * M2P + 32 * kk + 8 * fq);
            float csi[4];
#pragma unroll
            for (int i = 0; i < 4; ++i) csi[i] = csl[16 * wave + 4 * fq + i];
            float sc[8][4];
#pragma unroll
            for (int j = 0; j < 8; ++j) { pg8::f32x4 acc = {0.f, 0.f, 0.f, 0.f};
                if (j <= wave) {
#pragma unroll
                    for (int kk = 0; kk < 4; ++kk) { const bf16x8 bfv = *(const LAS bf16x8*)(R1 + (16 * j + fr) * M2P + 32 * kk + 8 * fq); acc = __builtin_amdgcn_mfma_f32_16x16x32_bf16(aC[kk], bfv, acc, 0, 0, 0); } }
                const int s = 16 * j + fr; const float css = csl[s];
#pragma unroll
                for (int i = 0; i < 4; ++i) { const int l_ = 16 * wave + 4 * fq + i; sc[j][i] = (s <= l_) ? acc[i] * __expf(csi[i] - css) : 0.f; } }
            pg8::f32x4 y[4];
#pragma unroll
            for (int pt = 0; pt < 4; ++pt) { pg8::f32x4 acc = {0.f, 0.f, 0.f, 0.f};
#pragma unroll
                for (int kk = 0; kk < 4; ++kk) { const bf16x8 bfv = *(const LAS bf16x8*)(Hs + (16 * pt + fr) * M2P + 32 * kk + 8 * fq); acc = __builtin_amdgcn_mfma_f32_16x16x32_bf16(aC[kk], bfv, acc, 0, 0, 0); }
#pragma unroll
                for (int i = 0; i < 4; ++i) acc[i] *= __expf(csi[i]);
                y[pt] = acc; }
            __syncthreads();
#pragma unroll
            for (int j = 0; j < 8; ++j)
#pragma unroll
                for (int i = 0; i < 4; ++i) R1[(16 * wave + 4 * fq + i) * M2P + 16 * j + fr] = (bf16)f2bf(sc[j][i]);
            LDS_WAIT();
#pragma unroll
            for (int kk = 0; kk < 4; ++kk) { if (32 * kk <= 16 * wave + 15) { const bf16x8 aS = *(const LAS bf16x8*)(R1 + (16 * wave + fr) * M2P + 32 * kk + 8 * fq);
#pragma unroll
                    for (int pt = 0; pt < 4; ++pt) { const bf16x8 bfv = *(const LAS bf16x8*)(XT + (16 * pt + fr) * M2P + 32 * kk + 8 * fq); y[pt] = __builtin_amdgcn_mfma_f32_16x16x32_bf16(aS, bfv, y[pt], 0, 0, 0); } } }
#pragma unroll
            for (int i = 0; i < 4; ++i) { const int l_ = 16 * wave + 4 * fq + i; const float rdt = Dh / dtl[l_];
#pragma unroll
                for (int pt = 0; pt < 4; ++pt) { const int p = 16 * pt + fr; const float yy = y[pt][i] + rdt * bf1(XT[p * M2P + l_]); R0[l_ * 72 + p] = (bf16)f2bf(yy); } }
            LDS_WAIT();
#pragma unroll
            for (int u = 0; u < 2; ++u) { const int rr = 16 * wave + (lane >> 2), ch = (lane & 3) * 2 + u; const v4u v = *(const LAS v4u*)(R0 + rr * 72 + ch * 8);
                *(v4u*)(MIX + (size_t)(tok0 + rr) * DMIX + 1024 + h * 64 + ch * 8) = v; }
        }
    }
    __syncthreads();
}
__device__ __forceinline__ void m2_carry(CArgs a, int gtid, int NT) {
    float* ST = (float*)(a->ws + WS_M2ST); const float* CD = (const float*)(a->ws + WS_M2CD);
    for (int idx = gtid; idx < 2 * 4 * 64 * 128; idx += NT) { const int bh = idx >> 13, e = idx & 8191; float* p = ST + (size_t)bh * M2NC * 8192 + e; const float* cd = CD + bh * M2NC; float hc = 0.f;
        for (int c0 = 0; c0 < M2NC; c0 += 32) { float t[32], d[32];
#pragma unroll
            for (int u = 0; u < 32; ++u) { t[u] = p[(size_t)(c0 + u) * 8192]; d[u] = cd[c0 + u]; }
#pragma unroll
            for (int u = 0; u < 32; ++u) { p[(size_t)(c0 + u) * 8192] = hc; hc = d[u] * hc + t[u]; } } }
    f32x2* S5 = (f32x2*)(a->ws + WS_S5ST); const f32x4* LB = (const f32x4*)(a->ws + WS_S5LB);
    for (int idx = NT - 1 - gtid; idx < 2048; idx += NT) { const int bg = idx >> 6, p = idx & 63; const f32x4 lb = LB[(bg & 15) * 64 + p]; f32x2* sp = S5 + (size_t)bg * S5NC * 64 + p; float xr = 0.f, xi = 0.f;
        for (int c0 = 0; c0 < S5NC; c0 += 32) { f32x2 t[32];
#pragma unroll
            for (int u = 0; u < 32; ++u) t[u] = sp[(c0 + u) * 64];
#pragma unroll
            for (int u = 0; u < 32; ++u) { sp[(c0 + u) * 64] = (f32x2){xr, xi}; const float nr = lb.z * xr - lb.w * xi + t[u].x, ni = lb.z * xi + lb.w * xr + t[u].y; xr = nr; xi = ni; } } }
}

template <int REP> __device__ __forceinline__ void p7_combine(CArgs a, int l, int gw, int NGW, int lane) {
    unsigned char* ws = a->ws; const bf16* OA = (const bf16*)(ws + WS_OA); bf16* MIX = (bf16*)(ws + WS_MIX); const bf16* Z = (const bf16*)(ws + WS_Z);
    const float linit = (l == 0) ? 0.2f : 0.35550906759096927f;
    const float* lp = a->in[I_DALAM] + l * 256;
    const float s1 = wave_sum(lp[lane] * lp[64 + lane]), s2 = wave_sum(lp[128 + lane] * lp[192 + lane]); const float lam = __expf(s1) - __expf(s2) + linit, osc = 1.f - linit;
    const int h = lane >> 4, e0 = (lane & 15) * 8, vh = e0 >> 6, d0 = e0 & 63; float sg[8], ng[4];
#pragma unroll
    for (int j = 0; j < 8; ++j) sg[j] = a->in[I_SUBG][l * 128 + e0 + j] * osc;
#pragma unroll
    for (int j = 0; j < 4; ++j) ng[j] = a->in[I_M2NG][l * 256 + lane * 4 + j];
    for (int tk = gw * 4; tk < M; tk += NGW * 4) {
        v4u q0[4], q1[4]; v2u yw[4], zw[4];
#pragma unroll
        for (int rr = 0; rr < 4; ++rr) { const int tok = tk + rr; const bf16* o = OA + (size_t)tok * 1024 + h * 256 + vh * 64 + d0; q0[rr] = *(const v4u*)o; q1[rr] = *(const v4u*)(o + 128);
            if constexpr (REP == 0) { yw[rr] = *(const v2u*)(MIX + (size_t)tok * DMIX + 1024 + lane * 4); zw[rr] = *(const v2u*)(Z + (size_t)tok * 256 + lane * 4); } }
#pragma unroll
        for (int rr = 0; rr < 4; ++rr) { const int tok = tk + rr;
        { float p0[8], p1[8], f[8]; unpack8(q0[rr], p0); unpack8(q1[rr], p1); float ss = 0.f;
#pragma unroll
          for (int j = 0; j < 8; ++j) { f[j] = p0[j] - lam * p1[j]; ss += f[j] * f[j]; }
          ss += __shfl_xor(ss, 1); ss += __shfl_xor(ss, 2); ss += __shfl_xor(ss, 4); ss += __shfl_xor(ss, 8); const float rs = rsqrtf(ss * (1.f / 128.f) + EPS);
#pragma unroll
          for (int j = 0; j < 8; ++j) f[j] = f[j] * rs * sg[j];
          *(v4u*)(MIX + (size_t)tok * DMIX + h * 128 + e0) = pack8(f); }
        if constexpr (REP == 0) { v2u* yp = (v2u*)(MIX + (size_t)tok * DMIX + 1024 + lane * 4); const v2u y2 = yw[rr], z2 = zw[rr];
          float v[4] = {bflo(y2.x) * siluf(bflo(z2.x)), bfhi(y2.x) * siluf(bfhi(z2.x)), bflo(y2.y) * siluf(bflo(z2.y)), bfhi(y2.y) * siluf(bfhi(z2.y))};
          const float ss = wave_sum((v[0] * v[0] + v[1] * v[1]) + (v[2] * v[2] + v[3] * v[3])); const float rs = rsqrtf(ss * (1.f / 256.f) + EPS);
          v2u w; w.x = pk2(v[0] * rs * ng[0], v[1] * rs * ng[1]); w.y = pk2(v[2] * rs * ng[2], v[3] * rs * ng[3]); *yp = w; } }
    }
}
typedef GAS unsigned gu32;
#define XB_TMO      128
#define XB_XCNT(j)  (256  + 64 * (j))
#define XB_XSUB(j)  (1280 + 64 * (j))
#define XB_XGEN(j)  (2304 + 64 * (j))
#define XB_TOP      3328
#define XB_TOPGEN   3392
#define XCD_BAR_WORDS 3456
#define XB_SPIN_CAP (1u << 18)

__device__ __forceinline__ unsigned xb_ld(unsigned* p)              { return __hip_atomic_load(p, __ATOMIC_RELAXED, __HIP_MEMORY_SCOPE_AGENT); }
__device__ __forceinline__ unsigned xb_add(unsigned* p, unsigned v) { return __hip_atomic_fetch_add(p, v, __ATOMIC_RELAXED, __HIP_MEMORY_SCOPE_AGENT); }
__device__ __forceinline__ unsigned xb_xcc_id() { return (unsigned)__builtin_amdgcn_s_getreg((3 << 11) | 20) & 0xFu; }
#define XB_SPIN(cond, bar) do { unsigned _sp = 0; while (cond) { __builtin_amdgcn_s_sleep(1); \
    if ((++_sp & 255u) == 0u) { if (xb_ld(&(bar)[XB_TMO])) break; if (_sp > XB_SPIN_CAP) { atomicAdd(&(bar)[XB_TMO], 1u); break; } } } } while (0)

struct XcdBarrier {
    unsigned* bar; unsigned x;
    volatile LAS unsigned* st;
};

__device__ __forceinline__ XcdBarrier xcd_barrier_post(unsigned* bar, volatile LAS unsigned* st) {
    XcdBarrier b; b.bar = bar; b.x = xb_xcc_id(); b.st = st;
    if (threadIdx.x == 0) (void)xb_add(&bar[XB_XCNT(b.x)], 1u);
    return b;
}
__device__ __forceinline__ void xcd_barrier_complete(unsigned* bar, unsigned x, unsigned& nloc, unsigned& nx) {
    const unsigned G = gridDim.x * gridDim.y * gridDim.z;
    unsigned sum, cnt, mine, sp = 0u;
    for (;;) {
        sum = 0u; cnt = 0u; mine = 0u;
#pragma unroll
        for (unsigned j = 0; j < 16; ++j) { const unsigned c = xb_ld(&bar[XB_XCNT(j)]); sum += c; cnt += (c > 0u) ? 1u : 0u; mine = (j == x) ? c : mine; }
        if (sum == G) break;
        __builtin_amdgcn_s_sleep(1);
        if ((++sp & 255u) == 0u) { if (xb_ld(&bar[XB_TMO])) break; if (sp > XB_SPIN_CAP) { atomicAdd(&bar[XB_TMO], 1u); break; } }
    }
    nloc = mine > 0u ? mine : 1u; nx = cnt > 0u ? cnt : 1u;
}

__device__ __forceinline__ void xcd_barrier(const XcdBarrier& b) {
    asm volatile("s_waitcnt vmcnt(0)" ::: "memory");
    __syncthreads();
    if (threadIdx.x == 0) {
        unsigned* bar = b.bar;
        __builtin_amdgcn_s_waitcnt(0);
        unsigned nloc = b.st[0], nx = b.st[1];
        if (nloc == 0u) { xcd_barrier_complete(bar, b.x, nloc, nx); b.st[0] = nloc; b.st[1] = nx; }
        const unsigned old = xb_add(&bar[XB_XSUB(b.x)], 1u);
        const unsigned gen = old / nloc;
        if (old + 1u == (gen + 1u) * nloc) {
            __builtin_amdgcn_fence(__ATOMIC_RELEASE, "agent");
            asm volatile("s_waitcnt vmcnt(0)" ::: "memory");
            const unsigned og = xb_add(&bar[XB_TOP], 1u);
            const unsigned tg = og / nx;
            if (og + 1u == (tg + 1u) * nx) xb_add(&bar[XB_TOPGEN], 1u);
            else XB_SPIN(xb_ld(&bar[XB_TOPGEN]) == tg, bar);
            __builtin_amdgcn_fence(__ATOMIC_ACQUIRE, "agent");
            xb_add(&bar[XB_XGEN(b.x)], 1u);
            asm volatile("s_waitcnt vmcnt(0)" ::: "memory");
        } else {
            XB_SPIN(xb_ld(&bar[XB_XGEN(b.x)]) == gen, bar);
            __builtin_amdgcn_fence(__ATOMIC_ACQUIRE, "agent");
            asm volatile("s_waitcnt vmcnt(0)" ::: "memory");
        }
    }
    __syncthreads();
}

constexpr int NPH = 11 * DEPTH;
#ifndef PHMASK
#define PHMASK 0x7ff
#endif
#define PHM(k) ((PHMASK >> (k)) & 1)
#ifndef DUPMASK
#define DUPMASK 0
#endif
template <int PH, int REP = 0> __device__ __forceinline__ void run_phase(CArgs a0, unsigned char* lds_raw) {
    LAS unsigned char* lds = (LAS unsigned char*)lds_raw;
        constexpr int l = PH / 11, k = PH % 11;
        int G_ = gridDim.x, bx_ = blockIdx.x; asm volatile("" : "+s"(G_), "+s"(bx_)); const int G = G_, bx = bx_; const int vcu = (G % 8 == 0) ? (bx % 8) * (G / 8) + bx / 8 : bx;
        const int NGW = G * NWAVES, NT = G * NTHR;
        int tid_ = threadIdx.x; asm volatile("" : "+v"(tid_)); const int tid = tid_, lane = tid & 63, wave = __builtin_amdgcn_readfirstlane(tid >> 6);
        const int gw = bx * NWAVES + wave, gtid = bx * NTHR + tid;
        CArgs a = a0; asm volatile("" : "+s"(a)); unsigned char* ws = a->ws;
        bf16* XB = (bf16*)(ws + WS_XB); float* ssq = (float*)(ws + WS_SSQ); bf16* MIX = (bf16*)(ws + WS_MIX);
        if constexpr (k == 0 && PHM(0)) { p0_convert<REP>(a, l, lds, gw, NGW, gtid, NT, wave, lane); }
        else if constexpr (k == 1 && PHM(1)) {
            pg8::Gemm g{XB, (const bf16*)(ws + WS_WIN), M, NPROJ, DM, DM}; pg8::StaticOrder S; S.init(M, NPROJ, G, bx);
            EpiInProj E{(bf16*)(ws + WS_QK), (bf16*)(ws + WS_V), (bf16*)(ws + WS_SC), (bf16*)(ws + WS_S5U), (bf16*)(ws + WS_Z), (bf16*)(ws + WS_XBC), (float*)(ws + WS_DTV), (const float*)(ws + WS_RSTD), a->in[I_M2DTB] + l * 4};
            pg8::gemm_phase<EpiInProj, pg8::StaticOrder, true, true>(lds, g, S, E);
        }
        else if constexpr (k == 2 && PHM(2)) { p2_prep<REP>(a, l, gw, NGW, gtid, NT, lane); s5_pass<false>(a, l, lds, gw, NGW, wave, lane); }
        else if constexpr (k == 3 && PHM(3)) { m2_pass<false>(a, l, lds, tid); }
        else if constexpr (k == 4 && PHM(4)) { m2_carry(a, gtid, NT); }
        else if constexpr (k == 5 && PHM(5)) { m2_pass<true>(a, l, lds, tid); s5_pass<true>(a, l, lds, gw, NGW, wave, lane); __syncthreads();
            const attn_body::bf16* QK = (const attn_body::bf16*)(ws + WS_QK);
            bool nomax; { float gq = __builtin_fabsf(a->in[I_QKG][l * 128 + lane]), gk = __builtin_fabsf(a->in[I_QKG][l * 128 + 64 + lane]);
#pragma unroll
                for (int o = 1; o < 64; o <<= 1) { gq = __builtin_fmaxf(gq, __shfl_xor(gq, o)); gk = __builtin_fmaxf(gk, __shfl_xor(gk, o)); }
                nomax = __builtin_amdgcn_readfirstlane((11.55f * gq * gk < 64.f) ? 1 : 0) != 0; }
            for (int q = vcu; q < 256; q += G) { const int bhc = q >> 4, s = q & 15, b = bhc >> 3, hd = (bhc >> 1) & 3, cc = bhc & 1;
                for (int i = 0; i < 2; ++i) { const int qb = (i == 0) ? s : 31 - s;
                    if (nomax) attn_body::attn_unit<8, false>(b, hd * 128 + cc * 64, hd * 128, hd * 256 + cc * 128, qb, QK, QK + 512, (const attn_body::bf16*)(ws + WS_V), (attn_body::bf16*)(ws + WS_OA), (char*)lds_raw);
                    else attn_body::attn_unit<8, true>(b, hd * 128 + cc * 64, hd * 128, hd * 256 + cc * 128, qb, QK, QK + 512, (const attn_body::bf16*)(ws + WS_V), (attn_body::bf16*)(ws + WS_OA), (char*)lds_raw); } }
        }
        else if constexpr (k == 6 && PHM(6)) {
            { constexpr int NGLU = M / 256;
              if (G > 2 * NGLU) { if (bx >= NGLU) p7_combine<REP>(a, l, (bx - NGLU) * NWAVES + wave, (G - NGLU) * NWAVES, lane); }
              else p7_combine<REP>(a, l, gw, NGW, lane); }
            if constexpr (REP == 0) {
            pg8::Gemm g{MIX + 768, (const bf16*)(ws + WS_WGLU), M, 256, 256, DMIX}; pg8::StaticOrder S; S.init(M, 256, G, bx);
            EpiGlu E{MIX, a->in[I_S5BGLU] + l * 256};
            pg8::gemm_phase<EpiGlu, pg8::StaticOrder, true, true>(lds, g, S, E); }
        }
        else if constexpr (k == 8 && PHM(8)) { rstd_reduce(a, gtid, NT); }
        else if constexpr (k == 7 && PHM(7)) {
            pg8::Gemm g{MIX, (const bf16*)(ws + WS_WOUT), M, DM, DMIX, DMIX}; pg8::StaticOrder S; S.init(M, DM, G, bx);
            typedef EpiResid<(l == 0), false> EpiR; EpiR E{a->in[I_X], a->out, XB, ssq};
            pg8::gemm_phase<EpiR, pg8::StaticOrder, true, true>(lds, g, S, E);
        }
        else if constexpr (k == 9 && PHM(9)) {
            pg8::Gemm g{XB - 2 * DM, (const bf16*)(ws + WS_WGU), FFN_MT * 256, 2 * DFF, DM, DM}; pg8::StaticOrder S; S.init(FFN_MT * 256, 2 * DFF, G, bx);
            EpiFfn1 E{(bf16*)(ws + WS_A2), (const float*)(ws + WS_RSTD), a->in[I_FCW] + l * 3 * DFF};
            pg8::gemm_phase<EpiFfn1, pg8::StaticOrder, true, true>(lds, g, S, E);
        }
        else if constexpr (k == 10 && PHM(10)) {
            pg8::Gemm g{(const bf16*)(ws + WS_A2), (const bf16*)(ws + WS_WDN), M, DM, DFF, DFF}; pg8::StaticOrder S; S.init(M, DM, G, bx);
            typedef EpiResid<false, (l == DEPTH - 1)> EpiR; EpiR E{nullptr, a->out, XB, ssq};
            pg8::gemm_phase<EpiR, pg8::StaticOrder, true, true>(lds, g, S, E);
        }
}
__global__ void __launch_bounds__(NTHR, 2) fwd_kernel(Args a_unused) {
    extern __shared__ __attribute__((aligned(16))) unsigned char lds_raw[];
    CArgs a0 = (CArgs)__builtin_amdgcn_kernarg_segment_ptr(); const int ph_lo = a0->ph_lo, ph_hi = a0->ph_hi;
    { volatile LAS unsigned* st = (volatile LAS unsigned*)((LAS unsigned char*)lds_raw + LDS_BARST); if (threadIdx.x < 2) st[threadIdx.x] = 0u; __syncthreads();
      if (ph_hi - ph_lo > 1) {
          unsigned* ctl = (unsigned*)(a0->ws + WS_CTL);
          if (blockIdx.x == 0) { for (int i = threadIdx.x; i < (int)(CTL_BYTES / 4); i += NTHR) __hip_atomic_store(ctl + i, 0u, __ATOMIC_RELAXED, __HIP_MEMORY_SCOPE_AGENT); asm volatile("s_waitcnt vmcnt(0)" ::: "memory"); }
          cg::this_grid().sync();
          (void)xcd_barrier_post(ctl, st); } }
#define SEAM(P) do { { CArgs ab = a0; asm volatile("" : "+s"(ab)); XcdBarrier bar; bar.bar = (unsigned*)(ab->ws + WS_CTL); bar.x = xb_xcc_id(); bar.st = (volatile LAS unsigned*)((LAS unsigned char*)lds_raw + LDS_BARST); xcd_barrier(bar); } } while (0)
#define RUNPH(P) if (ph_lo <= (P) && (P) < ph_hi) { run_phase<(P)>(a0, lds_raw); if constexpr ((DUPMASK >> ((P) % 11)) & 1) { SEAM(P); run_phase<(P), 1>(a0, lds_raw); } if ((P) + 1 < ph_hi) SEAM(P); }
    RUNPH(0) RUNPH(1) RUNPH(2) RUNPH(3) RUNPH(4) RUNPH(5) RUNPH(6) RUNPH(7) RUNPH(8) RUNPH(9) RUNPH(10)
    RUNPH(11) RUNPH(12) RUNPH(13) RUNPH(14) RUNPH(15) RUNPH(16) RUNPH(17) RUNPH(18) RUNPH(19) RUNPH(20) RUNPH(21)
#undef RUNPH
#undef SEAM
}

#ifndef ONE_LAUNCH
#define ONE_LAUNCH 1
#endif
extern "C" void kernel_launch(void* const* d_in, const int* in_sizes, int n_in, void* d_out, int out_size, void* d_ws, size_t ws_size, hipStream_t stream) {
    static int grid = 0;
    if (grid == 0) {
        if (n_in != 29 || out_size != M * DM || ws_size < WS_END) { fprintf(stderr, "kernel_launch: unexpected problem (n_in %d, out %d, ws %zu)\n", n_in, out_size, ws_size); grid = -1; return; }
        int dev = 0, cus = 0, per_cu = 0;
        if (hipGetDevice(&dev) != hipSuccess || hipDeviceGetAttribute(&cus, hipDeviceAttributeMultiprocessorCount, dev) != hipSuccess) { grid = -1; return; }
        if (hipFuncSetAttribute((const void*)fwd_kernel, hipFuncAttributeMaxDynamicSharedMemorySize, LDS_BYTES) != hipSuccess) { fprintf(stderr, "kernel_launch: hipFuncSetAttribute failed\n"); grid = -1; return; }
        if (hipOccupancyMaxActiveBlocksPerMultiprocessor(&per_cu, (const void*)fwd_kernel, NTHR, LDS_BYTES) != hipSuccess || per_cu < 1) { fprintf(stderr, "kernel_launch: occupancy query says %d\n", per_cu); (void)hipGetLastError(); grid = -1; return; }
        grid = cus * 1;
    }
    if (grid < 0) return;
    Args a{};
    for (int i = 0; i < 29; ++i) a.in[i] = (const float*)d_in[i];
    a.out = (float*)d_out; a.ws = (unsigned char*)d_ws;
    for (int i = 0; i < 8; ++i) { const float e = (float)(2 * i) / 16.0f; const float pw = powf(500000.0f, e); a.ropeinv[i] = 1.0f / pw; }
#if ONE_LAUNCH
    a.ph_lo = 0; a.ph_hi = NPH;
    void* args[] = {&a};
    hipError_t e = hipLaunchCooperativeKernel((const void*)fwd_kernel, dim3(grid), dim3(NTHR), args, LDS_BYTES, stream);
    if (e != hipSuccess) fprintf(stderr, "cooperative launch failed: %s (grid %d)\n", hipGetErrorString(e), grid);
#else
    for (int ph = 0; ph < NPH; ++ph) { a.ph_lo = ph; a.ph_hi = ph + 1; hipLaunchKernelGGL(fwd_kernel, dim3(grid), dim3(NTHR), LDS_BYTES, stream, a); }
#endif
}
```
